# Optimizing an MI355X kernel written in HIP

```python
import math
import jax, jax.numpy as jnp
from jax import lax
import numpy as np

D_MODEL = 1024
BATCH = 32
SEQ = 2048
DEPTH = 2

HEAD_DIM = 64
NSA_HEADS = 8
NSA_GROUPS = 2
NSA_HPG = NSA_HEADS // NSA_GROUPS
CMP_LEN = 32
CMP_STRIDE = 16
CMP_HIDDEN = 2 * HEAD_DIM
SLC_BLOCK = 64
SLC_TOPN = 8
WINDOW = 256
FORCE_BONUS = 1.0e4
DIFF_HEADS = 4
FOX_HEADS = 8
N_BRANCH = 3
BRANCH_WIDTH = 512
D_FF = 2816
CONV_W = 3
Q_BLOCK = 128
EPS = 1e-6
NEG = -1.0e30

NSA_Q = NSA_HEADS * HEAD_DIM
NSA_KV = 3 * 2 * NSA_GROUPS * HEAD_DIM
NSA_GATE = 3 * NSA_HEADS
DIFF_Q = DIFF_HEADS * 2 * HEAD_DIM
DIFF_K = DIFF_HEADS * 2 * HEAD_DIM
DIFF_V = DIFF_HEADS * 2 * HEAD_DIM
FOX_Q = FOX_HEADS * HEAD_DIM
FOX_K = FOX_HEADS * HEAD_DIM
FOX_V = FOX_HEADS * HEAD_DIM
FOX_F = FOX_HEADS
MERGE_G = N_BRANCH * D_MODEL
IN_SIZES = (NSA_Q, NSA_KV, NSA_GATE, DIFF_Q, DIFF_K, DIFF_V, FOX_Q, FOX_K, FOX_V, FOX_F, MERGE_G)
D_IN = NSA_Q + NSA_KV + NSA_GATE + DIFF_Q + DIFF_K + DIFF_V + FOX_Q + FOX_K + FOX_V + FOX_F + MERGE_G

kernel_name = "hybrid_nsa_diff_fox_convffn"


def rms_norm(x, g):
    xf = x.astype(jnp.float32)
    y = xf * lax.rsqrt(jnp.mean(xf * xf, axis=-1, keepdims=True) + EPS)
    return (y * g.astype(jnp.float32)).astype(x.dtype)


def alibi_slopes(n):
    return jnp.asarray(2.0 ** (-8.0 * np.arange(1, n + 1) / n), jnp.float32)


def masked_softmax(logits, mask):
    p = jax.nn.softmax(jnp.where(mask, logits, NEG), axis=-1)
    return jnp.where(mask, p, 0.0)


def unblock(y):
    y = jnp.moveaxis(y, 0, 1)
    return y.reshape((y.shape[0], y.shape[1] * y.shape[2]) + y.shape[3:])


def compress(raw, pe, w1, w2, idx):
    B = raw.shape[0]
    G, hd = raw.shape[2], raw.shape[3]
    nc, L = idx.shape
    blocks = raw[:, idx] + pe[:, None, :]
    flat = jnp.transpose(blocks, (0, 1, 3, 2, 4)).reshape(B, nc, G, L * hd)
    return jax.nn.gelu(flat @ w1) @ w2


def nsa_attention(q, k_cmp, v_cmp, k_slc, v_slc, k_win, v_win, gate_logits, cmp_end):
    B, S, H, hd = q.shape
    G, R = NSA_GROUPS, NSA_HPG
    nc = k_cmp.shape[1]
    ns = S // SLC_BLOCK
    n_sel = min(SLC_TOPN, ns)
    slopes = alibi_slopes(H).reshape(G, R)
    c_start = jnp.arange(nc) * CMP_STRIDE
    s_start = jnp.arange(ns) * SLC_BLOCK
    overlap = ((c_start[:, None] < s_start[None, :] + SLC_BLOCK)
               & (c_start[:, None] + CMP_LEN > s_start[None, :])).astype(jnp.float32)
    kb = jnp.transpose(k_slc.reshape(B, ns, SLC_BLOCK, G, hd), (0, 3, 1, 2, 4))
    vb = jnp.transpose(v_slc.reshape(B, ns, SLC_BLOCK, G, hd), (0, 3, 1, 2, 4))
    pad = ((0, 0), (WINDOW, 0), (0, 0), (0, 0))
    kw_pad = jnp.pad(k_win, pad)
    vw_pad = jnp.pad(v_win, pad)
    gather = jax.vmap(jax.vmap(lambda blocks, ix: blocks[ix]))
    blk_ids = jnp.arange(ns)
    sl = slopes[None, :, :, None]

    def chunk(c):
        t0 = c * Q_BLOCK
        tpos = t0 + jnp.arange(Q_BLOCK)
        qg = lax.dynamic_slice_in_dim(q, t0, Q_BLOCK, axis=1).reshape(B, Q_BLOCK, G, R, hd)
        dist_c = tpos[:, None] - cmp_end[None, :]
        s_c = jnp.einsum('btgrd,bngd->bgrtn', qg, k_cmp).astype(jnp.float32)
        s_c = s_c - sl[..., None] * dist_c.astype(jnp.float32)
        p_c = masked_softmax(s_c, dist_c >= 0)
        o_c = jnp.einsum('bgrtn,bngd->btgrd', p_c.astype(v_cmp.dtype), v_cmp)
        imp = jnp.einsum('bgrtn,nj->bgtj', p_c, overlap)
        cur = tpos // SLC_BLOCK
        causal_blk = blk_ids[None, :] <= cur[:, None]
        forced = ((blk_ids[None, :] == 0) | (blk_ids[None, :] == cur[:, None])
                  | (blk_ids[None, :] == cur[:, None] - 1))
        score = jnp.where(causal_blk, jnp.where(forced, imp + FORCE_BONUS, imp), NEG)
        sel = lax.top_k(score, n_sel)[1]
        ks = gather(kb, sel)
        vs = gather(vb, sel)
        spos = sel[..., None] * SLC_BLOCK + jnp.arange(SLC_BLOCK)
        dist_s = (tpos[None, None, :, None, None] - spos)[:, :, None]
        s_s = jnp.einsum('btgrd,bgtnkd->bgrtnk', qg, ks).astype(jnp.float32)
        s_s = s_s - sl[..., None, None] * dist_s.astype(jnp.float32)
        m = n_sel * SLC_BLOCK
        p_s = masked_softmax(s_s.reshape(B, G, R, Q_BLOCK, m),
                             (dist_s >= 0).reshape(B, G, 1, Q_BLOCK, m))
        o_s = jnp.einsum('bgrtm,bgtmd->btgrd', p_s.astype(vs.dtype),
                         vs.reshape(B, G, Q_BLOCK, m, hd))
        kw = lax.dynamic_slice_in_dim(kw_pad, t0, Q_BLOCK + WINDOW, axis=1)
        vw = lax.dynamic_slice_in_dim(vw_pad, t0, Q_BLOCK + WINDOW, axis=1)
        wpos = t0 - WINDOW + jnp.arange(Q_BLOCK + WINDOW)
        dist_w = tpos[:, None] - wpos[None, :]
        mask_w = (wpos[None, :] >= 0) & (dist_w >= 0) & (dist_w < WINDOW)
        s_w = jnp.einsum('btgrd,bsgd->bgrts', qg, kw).astype(jnp.float32)
        s_w = s_w - sl[..., None] * dist_w.astype(jnp.float32)
        p_w = masked_softmax(s_w, mask_w)
        o_w = jnp.einsum('bgrts,bsgd->btgrd', p_w.astype(vw.dtype), vw)
        gc = jax.nn.sigmoid(lax.dynamic_slice_in_dim(gate_logits, t0, Q_BLOCK, axis=1)
                            .reshape(B, Q_BLOCK, 3, G, R, 1))
        o = gc[:, :, 0] * o_c + gc[:, :, 1] * o_s + gc[:, :, 2] * o_w
        return o.reshape(B, Q_BLOCK, H * hd)

    return unblock(lax.map(chunk, jnp.arange(S // Q_BLOCK)))


def diff_attention(q, k, v, lam):
    B, S, H = q.shape[0], q.shape[1], q.shape[2]
    slopes = alibi_slopes(H)[None, :, None, None, None]
    kpos = jnp.arange(S)

    def chunk(c):
        t0 = c * Q_BLOCK
        tpos = t0 + jnp.arange(Q_BLOCK)
        qc = lax.dynamic_slice_in_dim(q, t0, Q_BLOCK, axis=1)
        dist = tpos[:, None] - kpos[None, :]
        s = jnp.einsum('bthcd,bshcd->bhcts', qc, k).astype(jnp.float32)
        s = s - slopes * dist.astype(jnp.float32)
        p = masked_softmax(s, dist >= 0)
        a = p[:, :, 0] - lam * p[:, :, 1]
        return jnp.einsum('bhts,bshe->bthe', a.astype(v.dtype), v)

    return unblock(lax.map(chunk, jnp.arange(S // Q_BLOCK)))


def forgetting_attention(q, k, v, log_f):
    S = q.shape[1]
    F = jnp.transpose(jnp.cumsum(log_f, axis=1), (0, 2, 1))
    kpos = jnp.arange(S)

    def chunk(c):
        t0 = c * Q_BLOCK
        tpos = t0 + jnp.arange(Q_BLOCK)
        qc = lax.dynamic_slice_in_dim(q, t0, Q_BLOCK, axis=1)
        Fc = lax.dynamic_slice_in_dim(F, t0, Q_BLOCK, axis=2)
        s = jnp.einsum('bthd,bshd->bhts', qc, k).astype(jnp.float32)
        s = s + Fc[..., :, None] - F[..., None, :]
        p = masked_softmax(s, tpos[:, None] >= kpos[None, :])
        return jnp.einsum('bhts,bshd->bthd', p.astype(v.dtype), v)

    return unblock(lax.map(chunk, jnp.arange(S // Q_BLOCK)))


def conv_ffn(h, w_up, conv_w, conv_b, w_down):
    S = h.shape[1]
    u, g = jnp.split(h @ w_up, 2, axis=-1)
    up = jnp.pad(u, ((0, 0), (CONV_W - 1, 0), (0, 0)))
    uc = conv_b
    for j in range(CONV_W):
        uc = uc + conv_w[j] * up[:, j:j + S]
    return (jax.nn.gelu(uc) * g) @ w_down


def setup_inputs(seed: int = 0) -> dict:
    key = jax.random.key(seed)
    ks = jax.random.split(key, 24)
    f32 = jnp.float32
    n = lambda k, shape, scale: (jax.random.normal(k, shape, f32) * scale)
    gain = lambda k, shape: 1.0 + 0.02 * jax.random.normal(k, shape, f32)
    L, hd = CMP_LEN, HEAD_DIM
    return {
        "x": jax.random.normal(ks[0], (BATCH, SEQ, D_MODEL), f32),
        "attn_norm_g": gain(ks[1], (DEPTH, D_MODEL)),
        "w_in": n(ks[2], (DEPTH, D_MODEL, D_IN), D_MODEL ** -0.5),
        "nsa_q_g": gain(ks[3], (DEPTH, hd)),
        "nsa_k_g": gain(ks[4], (DEPTH, 3, hd)),
        "cmp_pe": n(ks[5], (DEPTH, 2, L, hd), 0.02),
        "cmp_w1": n(ks[6], (DEPTH, 2, L * hd, CMP_HIDDEN), (L * hd) ** -0.5),
        "cmp_w2": n(ks[7], (DEPTH, 2, CMP_HIDDEN, hd), CMP_HIDDEN ** -0.5),
        "diff_q_g": gain(ks[8], (DEPTH, hd)),
        "diff_k_g": gain(ks[9], (DEPTH, hd)),
        "diff_lam": n(ks[10], (DEPTH, 4, hd), 0.1),
        "diff_subln_g": gain(ks[11], (DEPTH, 2 * hd)),
        "fox_q_g": gain(ks[12], (DEPTH, hd)),
        "fox_k_g": gain(ks[13], (DEPTH, hd)),
        "fox_b": jax.random.uniform(ks[14], (DEPTH, FOX_HEADS), f32, 1.0, 4.0),
        "w_br": n(ks[15], (DEPTH, N_BRANCH, BRANCH_WIDTH, D_MODEL), BRANCH_WIDTH ** -0.5),
        "w_o": n(ks[16], (DEPTH, D_MODEL, D_MODEL), D_MODEL ** -0.5),
        "ffn_norm_g": gain(ks[17], (DEPTH, D_MODEL)),
        "w_up": n(ks[18], (DEPTH, D_MODEL, 2 * D_FF), D_MODEL ** -0.5),
        "conv_w": n(ks[19], (DEPTH, CONV_W, D_FF), CONV_W ** -0.5),
        "conv_b": n(ks[20], (DEPTH, D_FF), 0.02),
        "w_down": n(ks[21], (DEPTH, D_FF, D_MODEL), D_FF ** -0.5),
    }


def reference(x, attn_norm_g, w_in, nsa_q_g, nsa_k_g, cmp_pe, cmp_w1, cmp_w2,
              diff_q_g, diff_k_g, diff_lam, diff_subln_g, fox_q_g, fox_k_g, fox_b,
              w_br, w_o, ffn_norm_g, w_up, conv_w, conv_b, w_down):
    B, S, D = x.shape
    hd = HEAD_DIM
    scale = hd ** -0.5
    split_points = [int(v) for v in np.cumsum(IN_SIZES)[:-1]]
    nc = (S - CMP_LEN) // CMP_STRIDE + 1
    cmp_idx = jnp.arange(nc)[:, None] * CMP_STRIDE + jnp.arange(CMP_LEN)[None, :]
    cmp_end = cmp_idx[:, -1]
    h = x
    for l in range(DEPTH):
        a = rms_norm(h, attn_norm_g[l])
        (nq, nkv, ngate, dq, dk, dv, fq, fk, fv, ff, mg) = jnp.split(a @ w_in[l], split_points, axis=-1)

        qa = rms_norm(nq.reshape(B, S, NSA_HEADS, hd), nsa_q_g[l]) * scale
        kv = nkv.reshape(B, S, 3, 2, NSA_GROUPS, hd)
        k_cmp = rms_norm(compress(kv[:, :, 0, 0], cmp_pe[l, 0], cmp_w1[l, 0], cmp_w2[l, 0], cmp_idx),
                         nsa_k_g[l, 0])
        v_cmp = compress(kv[:, :, 0, 1], cmp_pe[l, 1], cmp_w1[l, 1], cmp_w2[l, 1], cmp_idx)
        k_slc = rms_norm(kv[:, :, 1, 0], nsa_k_g[l, 1])
        k_win = rms_norm(kv[:, :, 2, 0], nsa_k_g[l, 2])
        o_a = nsa_attention(qa, k_cmp, v_cmp, k_slc, kv[:, :, 1, 1], k_win, kv[:, :, 2, 1],
                            ngate.reshape(B, S, 3, NSA_HEADS), cmp_end)

        lam_init = 0.8 - 0.6 * math.exp(-0.3 * l)
        lv = diff_lam[l].astype(jnp.float32)
        lam = jnp.exp(jnp.sum(lv[0] * lv[1])) - jnp.exp(jnp.sum(lv[2] * lv[3])) + lam_init
        qb = rms_norm(dq.reshape(B, S, DIFF_HEADS, 2, hd), diff_q_g[l]) * scale
        kb = rms_norm(dk.reshape(B, S, DIFF_HEADS, 2, hd), diff_k_g[l])
        ob = diff_attention(qb, kb, dv.reshape(B, S, DIFF_HEADS, 2 * hd), lam)
        o_b = (rms_norm(ob, diff_subln_g[l]) * (1.0 - lam_init)).reshape(B, S, BRANCH_WIDTH)

        qc = rms_norm(fq.reshape(B, S, FOX_HEADS, hd), fox_q_g[l]) * scale
        kc = rms_norm(fk.reshape(B, S, FOX_HEADS, hd), fox_k_g[l])
        log_f = jax.nn.log_sigmoid((ff + fox_b[l]).astype(jnp.float32))
        o_c = forgetting_attention(qc, kc, fv.reshape(B, S, FOX_HEADS, hd), log_f).reshape(B, S, BRANCH_WIDTH)

        gates = jax.nn.sigmoid(mg.reshape(B, S, N_BRANCH, D))
        merged = (gates[:, :, 0] * (o_a @ w_br[l, 0]) + gates[:, :, 1] * (o_b @ w_br[l, 1])
                  + gates[:, :, 2] * (o_c @ w_br[l, 2]))
        h = h + merged @ w_o[l]

        h = h + conv_ffn(rms_norm(h, ffn_norm_g[l]), w_up[l], conv_w[l], conv_b[l], w_down[l])
    return h
```

```cpp
#include <hip/hip_runtime.h>
#include <hip/hip_cooperative_groups.h>
#include <cstdio>
#include <cstdint>
namespace cg = cooperative_groups;
namespace pg8 {
#define PG8_LAS __attribute__((address_space(3)))
typedef unsigned short bf16_t;
typedef short bf16x8 __attribute__((ext_vector_type(8)));
typedef float f32x4 __attribute__((ext_vector_type(4)));
typedef unsigned u32x4 __attribute__((ext_vector_type(4)));
constexpr int BM = 256, BK = 64, HALF = 128, HTB = HALF * BK * 2  , STAGE_BYTES = 8 * HTB, NXCD = 8, WGM = 8;

__host__ __device__ __forceinline__ int lds_byte(int r, int c) { const int st = (r >> 4) * 2 + (c >> 5), rr = r & 15, cc = c & 31, ob = rr * 64 + cc * 2; return st * 1024 + (ob ^ (((ob >> 9) & 1) << 5)); }
__host__ __device__ __forceinline__ void stage_rc(int b, int& R, int& C) { const int st = b / 1024, sb = b % 1024, swz = sb ^ (((sb >> 9) & 1) << 5); R = (st >> 1) * 16 + swz / 64; C = (st & 1) * 32 + (swz % 64) / 2; }
__host__ __device__ __forceinline__ int perm32(int rho) { const int n = rho >> 4, i = rho & 15; return 8 * (i >> 2) + 4 * n + (i & 3); }

struct Unit { int pm, pn; };
struct Gemm { const bf16_t* A; const bf16_t* Bt; int M, N, K; };

struct StaticOrder {
    int nM, nN, nwg, G, c;
    __host__ __device__ void init(int M, int N, int G_, int c_) { nM = M / BM; nN = N / BM; nwg = nM * nN; G = G_; c = c_; }
    __host__ __device__ bool next(int i, Unit& u) const {
        const long L = (long)i * G + c; if (L >= nwg) return false;
        int wgid = (int)L; { const int q = nwg / NXCD, r = nwg % NXCD, xcd = wgid % NXCD, off = wgid / NXCD; wgid = (xcd < r ? xcd * (q + 1) : r * (q + 1) + (xcd - r) * q) + off; }
        const int nig = WGM * nN, gid = wgid / nig, fm = gid * WGM, gsz = (nM - fm) < WGM ? (nM - fm) : WGM;
        u.pm = fm + ((wgid % nig) % gsz); u.pn = (wgid % nig) / gsz; return true;
    }
    __device__ __forceinline__ void a_ready(const Unit&) const {}
    __device__ __forceinline__ void done(const Unit&) const {}
};
typedef float f32x2c_t __attribute__((ext_vector_type(2))); typedef __bf16 bf16x2c_t __attribute__((ext_vector_type(2)));
__device__ __forceinline__ unsigned cvt_pk_bf16(float lo, float hi) { const f32x2c_t v = {lo, hi}; const bf16x2c_t r = __builtin_convertvector(v, bf16x2c_t); return __builtin_bit_cast(unsigned, r); }
typedef unsigned u32x2 __attribute__((ext_vector_type(2)));
__device__ __forceinline__ float sigmoidf_(float x) { return __builtin_amdgcn_rcpf(1.0f + __builtin_amdgcn_exp2f(-1.4426950408889634f * x)); }
__device__ __forceinline__ float bf2f_(unsigned short v) { return __uint_as_float(((unsigned)v) << 16); }

struct EpiIn {
    static constexpr bool PERM = true, AFTER_DRAIN = false, HOOK = false;
    bf16_t* PH; bf16_t* MG; float* GT;
    const float *nsa_q_g, *nsa_k_g, *diff_q_g, *diff_k_g, *fox_q_g, *fox_k_g;
    __device__ __forceinline__ void operator()(const f32x4 (&acc)[2][2][4][2], const Unit& u, int wr, int wc, int fr, int fq) const {
        const int row0 = u.pm * BM + wr * 64 + fr;
        if (u.pn < 17) {
            const int head = 4 * u.pn + wc;
            const float* gp = nullptr; float sc = 1.0f;
            if (head < 8) { gp = nsa_q_g; sc = 0.125f * 1.4426950408889634f; }
            else if (head < 20) { const int hh = head - 8, br = hh >> 2, kv = (hh >> 1) & 1; if (kv == 0 && br >= 1) gp = nsa_k_g + br * 64; }
            else if (head < 28) { gp = diff_q_g; sc = 0.125f * 1.4426950408889634f; }
            else if (head < 36) { gp = diff_k_g; }
            else if (head < 44) { }
            else if (head < 52) { gp = fox_q_g; sc = 0.125f * 1.4426950408889634f; }
            else if (head < 60) { gp = fox_k_g; }
            f32x4 gv[2][2];
#pragma unroll
            for (int bj = 0; bj < 2; ++bj)
#pragma unroll
                for (int n = 0; n < 2; ++n) gv[bj][n] = gp ? *(const f32x4*)(gp + 32 * bj + 8 * fq + 4 * n) : (f32x4){1.f, 1.f, 1.f, 1.f};
            float rr[2][4];
#pragma unroll
            for (int ai = 0; ai < 2; ++ai)
#pragma unroll
                for (int m = 0; m < 4; ++m) rr[ai][m] = 1.0f;
            if (gp) {
                const int lane_ = fr + 16 * fq, a16 = (lane_ ^ 16) << 2, a32 = (lane_ ^ 32) << 2;
                float ss[2][4], t1[2][4];
#pragma unroll
                for (int ai = 0; ai < 2; ++ai)
#pragma unroll
                    for (int m = 0; m < 4; ++m) { float s = 0.f;
#pragma unroll
                        for (int bj = 0; bj < 2; ++bj)
#pragma unroll
                            for (int n = 0; n < 2; ++n) { const f32x4 x = acc[ai][bj][m][n]; s += (x[0] * x[0] + x[1] * x[1]) + (x[2] * x[2] + x[3] * x[3]); }
                        ss[ai][m] = s; }
#pragma unroll
                for (int ai = 0; ai < 2; ++ai)
#pragma unroll
                    for (int m = 0; m < 4; ++m) t1[ai][m] = __int_as_float(__builtin_amdgcn_ds_bpermute(a16, __float_as_int(ss[ai][m])));
#pragma unroll
                for (int ai = 0; ai < 2; ++ai)
#pragma unroll
                    for (int m = 0; m < 4; ++m) ss[ai][m] += t1[ai][m];
#pragma unroll
                for (int ai = 0; ai < 2; ++ai)
#pragma unroll
                    for (int m = 0; m < 4; ++m) t1[ai][m] = __int_as_float(__builtin_amdgcn_ds_bpermute(a32, __float_as_int(ss[ai][m])));
#pragma unroll
                for (int ai = 0; ai < 2; ++ai)
#pragma unroll
                    for (int m = 0; m < 4; ++m) rr[ai][m] = __builtin_amdgcn_rsqf((ss[ai][m] + t1[ai][m]) * (1.0f / 64.0f) + 1e-6f) * sc;
            }
#pragma unroll
            for (int ai = 0; ai < 2; ++ai)
#pragma unroll
                for (int m = 0; m < 4; ++m) {
                    const float r = rr[ai][m];
                    bf16_t* rowp = PH + (size_t)(row0 + ai * HALF + m * 16) * 4352 + head * 64 + 8 * fq;
#pragma unroll
                    for (int bj = 0; bj < 2; ++bj) { const f32x4 v0 = acc[ai][bj][m][0] * r * gv[bj][0], v1 = acc[ai][bj][m][1] * r * gv[bj][1];
                        u32x4 w; w.x = cvt_pk_bf16(v0[0], v0[1]); w.y = cvt_pk_bf16(v0[2], v0[3]); w.z = cvt_pk_bf16(v1[0], v1[1]); w.w = cvt_pk_bf16(v1[2], v1[3]); *(u32x4*)(rowp + 32 * bj) = w; }
                }
        } else if (u.pn < 29) {
            const int col0 = (u.pn - 17) * BM + wc * 32 + 8 * fq;
#pragma unroll
            for (int ai = 0; ai < 2; ++ai)
#pragma unroll
                for (int m = 0; m < 4; ++m) {
                    bf16_t* rowp = MG + (size_t)(row0 + ai * HALF + m * 16) * 3072 + col0;
#pragma unroll
                    for (int bj = 0; bj < 2; ++bj) { const f32x4 v0 = acc[ai][bj][m][0], v1 = acc[ai][bj][m][1];
                        u32x4 w; w.x = cvt_pk_bf16(sigmoidf_(v0[0]), sigmoidf_(v0[1])); w.y = cvt_pk_bf16(sigmoidf_(v0[2]), sigmoidf_(v0[3])); w.z = cvt_pk_bf16(sigmoidf_(v1[0]), sigmoidf_(v1[1])); w.w = cvt_pk_bf16(sigmoidf_(v1[2]), sigmoidf_(v1[3]));
                        *(u32x4*)(rowp + bj * HALF) = w; }
                }
        } else {
            if (wc == 0) {
#pragma unroll
                for (int ai = 0; ai < 2; ++ai)
#pragma unroll
                    for (int m = 0; m < 4; ++m) {
                        float* rowp = GT + (size_t)(row0 + ai * HALF + m * 16) * 32 + 8 * fq;
#pragma unroll
                        for (int n = 0; n < 2; ++n) *(f32x4*)(rowp + 4 * n) = acc[ai][0][m][n];
                    }
            }
        }
    }
};

struct EpiMerge {
    static constexpr bool PERM = true, AFTER_DRAIN = false, HOOK = true;
    const bf16_t* MG; bf16_t* XN;
    __device__ __forceinline__ void gate8(const bf16_t* p, f32x4& g0, f32x4& g1) const {
        const u32x4 w = *(const u32x4*)p;
        g0[0] = __uint_as_float(w.x << 16); g0[1] = __uint_as_float(w.x & 0xffff0000u); g0[2] = __uint_as_float(w.y << 16); g0[3] = __uint_as_float(w.y & 0xffff0000u);
        g1[0] = __uint_as_float(w.z << 16); g1[1] = __uint_as_float(w.z & 0xffff0000u); g1[2] = __uint_as_float(w.w << 16); g1[3] = __uint_as_float(w.w & 0xffff0000u);
    }
    __device__ __forceinline__ void cvt8(const u32x4 w, f32x4& g0, f32x4& g1) const {
        g0[0] = __uint_as_float(w.x << 16); g0[1] = __uint_as_float(w.x & 0xffff0000u); g0[2] = __uint_as_float(w.y << 16); g0[3] = __uint_as_float(w.y & 0xffff0000u);
        g1[0] = __uint_as_float(w.z << 16); g1[1] = __uint_as_float(w.z & 0xffff0000u); g1[2] = __uint_as_float(w.w << 16); g1[3] = __uint_as_float(w.w & 0xffff0000u);
    }
    __device__ __forceinline__ void hook(f32x4 (&acc)[2][2][4][2], const Unit& u, int seg, int wr, int wc, int fr_, int fq_) const {
        int fr = fr_, fq = fq_; asm volatile("" : "+v"(fr), "+v"(fq));
        const int row0 = u.pm * BM + wr * 64 + fr, col0 = u.pn * BM + wc * 32 + 8 * fq;
#pragma unroll
        for (int ai = 0; ai < 2; ++ai) {
            u32x4 wa[4][2], wb[4][2];
#pragma unroll
            for (int m = 0; m < 4; ++m) {
                const bf16_t* gp = MG + (size_t)(row0 + ai * HALF + m * 16) * 3072 + (seg - 1) * 1024 + col0;
#pragma unroll
                for (int bj = 0; bj < 2; ++bj) { wa[m][bj] = *(const u32x4*)(gp + bj * HALF); wb[m][bj] = *(const u32x4*)(gp + 1024 + bj * HALF); }
            }
            __builtin_amdgcn_sched_barrier(0);
#pragma unroll
            for (int m = 0; m < 4; ++m)
#pragma unroll
                for (int bj = 0; bj < 2; ++bj) {
                    f32x4 a0, a1, b0, b1; cvt8(wa[m][bj], a0, a1); cvt8(wb[m][bj], b0, b1);
#pragma unroll
                    for (int i = 0; i < 4; ++i) { acc[ai][bj][m][0][i] *= a0[i] * __builtin_amdgcn_rcpf(b0[i]); acc[ai][bj][m][1][i] *= a1[i] * __builtin_amdgcn_rcpf(b1[i]); }
                }
            __builtin_amdgcn_sched_barrier(0);
        }
    }
    __device__ __forceinline__ void operator()(const f32x4 (&acc)[2][2][4][2], const Unit& u, int wr, int wc, int fr, int fq) const {
        const int row0 = u.pm * BM + wr * 64 + fr, col0 = u.pn * BM + wc * 32 + 8 * fq;
#pragma unroll
        for (int ai = 0; ai < 2; ++ai) {
            u32x4 wg[4][2];
#pragma unroll
            for (int m = 0; m < 4; ++m)
#pragma unroll
                for (int bj = 0; bj < 2; ++bj) wg[m][bj] = *(const u32x4*)(MG + (size_t)(row0 + ai * HALF + m * 16) * 3072 + 2048 + col0 + bj * HALF);
            __builtin_amdgcn_sched_barrier(0);
#pragma unroll
            for (int m = 0; m < 4; ++m) {
                const size_t row = (size_t)(row0 + ai * HALF + m * 16);
#pragma unroll
                for (int bj = 0; bj < 2; ++bj) {
                    f32x4 g0, g1; cvt8(wg[m][bj], g0, g1);
                    const f32x4 v0 = acc[ai][bj][m][0] * g0, v1 = acc[ai][bj][m][1] * g1;
                    u32x4 w; w.x = cvt_pk_bf16(v0[0], v0[1]); w.y = cvt_pk_bf16(v0[2], v0[3]); w.z = cvt_pk_bf16(v1[0], v1[1]); w.w = cvt_pk_bf16(v1[2], v1[3]);
                    *(u32x4*)(XN + row * 1024 + col0 + bj * HALF) = w;
                }
            }
        }
    }
};

template <bool BASE_BF16, bool OUT_BF16> struct EpiRes {
    static constexpr bool PERM = true, AFTER_DRAIN = false, HOOK = false;
    const void* base; void* out;
    __device__ __forceinline__ void operator()(const f32x4 (&acc)[2][2][4][2], const Unit& u, int wr, int wc, int fr, int fq) const {
        const int row0 = u.pm * BM + wr * 64 + fr, col0 = u.pn * BM + wc * 32 + 8 * fq;
#pragma unroll
        for (int ai = 0; ai < 2; ++ai) {
            f32x4 b0[4][2], b1[4][2];
#pragma unroll
            for (int m = 0; m < 4; ++m) {
                const size_t off = (size_t)(row0 + ai * HALF + m * 16) * 1024 + col0;
#pragma unroll
                for (int bj = 0; bj < 2; ++bj) {
                    if (BASE_BF16) { const u32x4 w = *(const u32x4*)((const bf16_t*)base + off + bj * HALF);
                        b0[m][bj][0] = __uint_as_float(w.x << 16); b0[m][bj][1] = __uint_as_float(w.x & 0xffff0000u); b0[m][bj][2] = __uint_as_float(w.y << 16); b0[m][bj][3] = __uint_as_float(w.y & 0xffff0000u);
                        b1[m][bj][0] = __uint_as_float(w.z << 16); b1[m][bj][1] = __uint_as_float(w.z & 0xffff0000u); b1[m][bj][2] = __uint_as_float(w.w << 16); b1[m][bj][3] = __uint_as_float(w.w & 0xffff0000u); }
                    else { b0[m][bj] = *(const f32x4*)((const float*)base + off + bj * HALF); b1[m][bj] = *(const f32x4*)((const float*)base + off + bj * HALF + 4); }
                }
            }
            __builtin_amdgcn_sched_barrier(0);
#pragma unroll
            for (int m = 0; m < 4; ++m) {
                const size_t off = (size_t)(row0 + ai * HALF + m * 16) * 1024 + col0;
#pragma unroll
                for (int bj = 0; bj < 2; ++bj) {
                    const f32x4 v0 = b0[m][bj] + acc[ai][bj][m][0], v1 = b1[m][bj] + acc[ai][bj][m][1];
                    if (OUT_BF16) { u32x4 w; w.x = cvt_pk_bf16(v0[0], v0[1]); w.y = cvt_pk_bf16(v0[2], v0[3]); w.z = cvt_pk_bf16(v1[0], v1[1]); w.w = cvt_pk_bf16(v1[2], v1[3]); *(u32x4*)((bf16_t*)out + off + bj * HALF) = w; }
                    else { *(f32x4*)((float*)out + off + bj * HALF) = v0; *(f32x4*)((float*)out + off + bj * HALF + 4) = v1; }
                }
            }
        }
    }
};

struct EpiStore {
    static constexpr bool PERM = true, AFTER_DRAIN = false, HOOK = false;
    bf16_t* O; int ldc;
    __device__ __forceinline__ void operator()(const f32x4 (&acc)[2][2][4][2], const Unit& u, int wr, int wc, int fr, int fq) const {
        const int row0 = u.pm * BM + wr * 64 + fr, col0 = u.pn * BM + wc * 32 + 8 * fq;
#pragma unroll
        for (int ai = 0; ai < 2; ++ai)
#pragma unroll
            for (int m = 0; m < 4; ++m) {
                bf16_t* rowp = O + (size_t)(row0 + ai * HALF + m * 16) * ldc + col0;
#pragma unroll
                for (int bj = 0; bj < 2; ++bj) { const f32x4 v0 = acc[ai][bj][m][0], v1 = acc[ai][bj][m][1];
                    u32x4 w; w.x = cvt_pk_bf16(v0[0], v0[1]); w.y = cvt_pk_bf16(v0[2], v0[3]); w.z = cvt_pk_bf16(v1[0], v1[1]); w.w = cvt_pk_bf16(v1[2], v1[3]); *(u32x4*)(rowp + bj * HALF) = w; }
            }
    }
};

template <class Epi, class Sched, bool ALIGN_EPI = false, bool SP2 = false>
__device__ __forceinline__ void gemm_phase(PG8_LAS unsigned char* lds, const Gemm g, const Sched& S, const Epi& E) {
    int tid_l = threadIdx.x; asm volatile("" : "+v"(tid_l));
    const int tid = tid_l, wid = __builtin_amdgcn_readfirstlane(tid >> 6), lane = tid & 63, wr = wid >> 2, wc = wid & 3, fr = lane & 15, fq = lane >> 4;
    const int K = g.K, nt = K / BK;
    unsigned voffA[2], voffB[2];
#pragma unroll
    for (int i = 0; i < 2; ++i) { int R, C; stage_rc(tid * 16 + i * 8192, R, C); const int Rb = Epi::PERM ? ((R & ~31) + perm32(R & 31)) : R;
        voffA[i] = (unsigned)(R * K + C) * 2u; voffB[i] = (unsigned)(Rb * K + C) * 2u; }
    const size_t kstep = (size_t)(BK * 2);
    const size_t hstep = (size_t)HALF * K * 2;
    const size_t tstep = 2 * hstep;
    const unsigned ldsw = (unsigned)wid * 1024u;
    const int aoff = lds_byte(wr * 64 + fr, fq * 8), boff = lds_byte(wc * 32 + fr, fq * 8);
#define PG8_SA(b, h) (((b) * 2 + (h)) * HTB)
#define PG8_SB(b, h) ((4 + (b) * 2 + (h)) * HTB)
#define PG8_STAGE(bufoff, gbase, voff) do { _Pragma("unroll") for (int _i = 0; _i < 2; ++_i) \
        __builtin_amdgcn_global_load_lds((const unsigned*)((const char*)(gbase) + (voff)[_i]), (PG8_LAS unsigned*)(lds + (bufoff) + ldsw + _i * 8192), 16, 0, 0); } while (0)
#define PG8_LDA(dst, b, h) do { _Pragma("unroll") for (int m = 0; m < 4; ++m) _Pragma("unroll") for (int k = 0; k < 2; ++k) dst[m][k] = *(const PG8_LAS bf16x8*)(lds + PG8_SA(b, h) + aoff + m * 2048 + k * 1024); } while (0)
#define PG8_LDB(dst, b, h) do { _Pragma("unroll") for (int n = 0; n < 2; ++n) _Pragma("unroll") for (int k = 0; k < 2; ++k) dst[n][k] = *(const PG8_LAS bf16x8*)(lds + PG8_SB(b, h) + boff + n * 2048 + k * 1024); } while (0)
#define PG8_MMA(ai, bj, At, Bt) do { __builtin_amdgcn_s_setprio(1); _Pragma("unroll") for (int m = 0; m < 4; ++m) _Pragma("unroll") for (int n = 0; n < 2; ++n) _Pragma("unroll") for (int k = 0; k < 2; ++k) \
        acc[ai][bj][m][n] = __builtin_amdgcn_mfma_f32_16x16x32_bf16(Bt[n][k], At[m][k], acc[ai][bj][m][n], 0, 0, 0); __builtin_amdgcn_s_setprio(0); } while (0)
#define PG8_WAIT_V(n) asm volatile("s_waitcnt vmcnt(" #n ")" ::: "memory")
#define PG8_WAIT_L(n) asm volatile("s_waitcnt lgkmcnt(" #n ")" ::: "memory")
#define PG8_BAR __builtin_amdgcn_s_barrier()
#define PG8_SCHED __builtin_amdgcn_sched_barrier(0)
    Unit cur, nxt; int ui = 0;
    if (!S.next(0, cur)) return;
    f32x4 acc[2][2][4][2];
#pragma unroll
    for (int a = 0; a < 2; ++a)
#pragma unroll
        for (int b = 0; b < 2; ++b)
#pragma unroll
            for (int m = 0; m < 4; ++m)
#pragma unroll
                for (int n = 0; n < 2; ++n) acc[a][b][m][n] = (f32x4){0.f, 0.f, 0.f, 0.f};
    bf16x8 At[4][2], B0[2][2], B1[2][2];
    const char* cA = (const char*)g.A + (size_t)cur.pm * tstep; const char* cB = (const char*)g.Bt + (size_t)cur.pn * tstep;
    S.a_ready(cur);
    if constexpr (SP2) {
        PG8_STAGE(PG8_SB(0, 0), cB, voffB); PG8_STAGE(PG8_SB(0, 1), cB + hstep, voffB); PG8_STAGE(PG8_SA(0, 0), cA, voffA); PG8_STAGE(PG8_SA(0, 1), cA + hstep, voffA);
        if (wr == 1) PG8_BAR;
        PG8_WAIT_V(2); PG8_BAR;
        PG8_STAGE(PG8_SB(1, 0), cB + kstep, voffB); PG8_STAGE(PG8_SA(1, 0), cA + kstep, voffA); PG8_STAGE(PG8_SB(1, 1), cB + hstep + kstep, voffB);
        PG8_WAIT_V(6); PG8_BAR;
    } else {
        PG8_STAGE(PG8_SB(0, 0), cB, voffB); PG8_STAGE(PG8_SA(0, 0), cA, voffA); PG8_STAGE(PG8_SB(0, 1), cB + hstep, voffB); PG8_STAGE(PG8_SA(0, 1), cA + hstep, voffA);
        if (wr == 1) PG8_BAR;
        PG8_WAIT_V(4); PG8_BAR;
        PG8_STAGE(PG8_SB(1, 0), cB + kstep, voffB); PG8_STAGE(PG8_SA(1, 0), cA + kstep, voffA); PG8_STAGE(PG8_SB(1, 1), cB + hstep + kstep, voffB);
        PG8_WAIT_V(6); PG8_BAR;
    }
    for (;;) {
        const bool has_next = S.next(ui + 1, nxt);
        const char* nA = has_next ? (const char*)g.A + (size_t)nxt.pm * tstep : cA; const char* nB = has_next ? (const char*)g.Bt + (size_t)nxt.pn * tstep : cB;
        const int nseg = Epi::HOOK ? 3 : 1, segt = nt / nseg;
        for (int seg = 0; seg < nseg; ++seg) {
        if constexpr (Epi::HOOK) { if (seg > 0) { __builtin_amdgcn_sched_barrier(0); E.hook(acc, cur, seg, wr, wc, fr, fq); __builtin_amdgcn_sched_barrier(0); } }
        for (int t = seg * segt; t < (seg + 1) * segt; t += 2) {
            const bool last = (t == nt - 2);
            const char* a1 = cA + (size_t)(t + 1) * kstep;
            const char* a2 = last ? nA : cA + (size_t)(t + 2) * kstep; const char* b2 = last ? nB : cB + (size_t)(t + 2) * kstep;
            const char* a3 = a2 + kstep; const char* b3 = b2 + kstep;
            if (last && has_next) S.a_ready(nxt);
            if constexpr (SP2) {
            PG8_LDB(B0, 0, 0); PG8_LDB(B1, 0, 1); PG8_SCHED; PG8_LDA(At, 0, 0); PG8_STAGE(PG8_SA(1, 1), a1 + hstep, voffA);
            PG8_WAIT_V(8); PG8_WAIT_L(0); PG8_BAR; PG8_MMA(0, 0, At, B0); PG8_MMA(0, 1, At, B1); PG8_BAR; PG8_SCHED;
            PG8_LDA(At, 0, 1); PG8_STAGE(PG8_SB(0, 0), b2, voffB); PG8_STAGE(PG8_SB(0, 1), b2 + hstep, voffB); PG8_STAGE(PG8_SA(0, 0), a2, voffA);
            PG8_WAIT_V(8); PG8_WAIT_L(0); PG8_BAR; PG8_MMA(1, 0, At, B0); PG8_MMA(1, 1, At, B1); PG8_BAR; PG8_SCHED;
            PG8_LDB(B0, 1, 0); PG8_LDB(B1, 1, 1); PG8_SCHED; PG8_LDA(At, 1, 0); PG8_STAGE(PG8_SA(0, 1), a2 + hstep, voffA);
            PG8_WAIT_V(8); PG8_WAIT_L(0); PG8_BAR; PG8_MMA(0, 0, At, B0); PG8_MMA(0, 1, At, B1); PG8_BAR; PG8_SCHED;
            PG8_LDA(At, 1, 1); PG8_STAGE(PG8_SB(1, 0), b3, voffB); PG8_STAGE(PG8_SB(1, 1), b3 + hstep, voffB); PG8_STAGE(PG8_SA(1, 0), a3, voffA);
            PG8_WAIT_V(8); PG8_WAIT_L(0); PG8_BAR; PG8_MMA(1, 0, At, B0); PG8_MMA(1, 1, At, B1); PG8_BAR; PG8_SCHED;
            } else {
            PG8_LDB(B0, 0, 0); PG8_SCHED; PG8_LDA(At, 0, 0); PG8_STAGE(PG8_SA(1, 1), a1 + hstep, voffA);
            PG8_WAIT_L(8); PG8_BAR; PG8_WAIT_L(0); PG8_MMA(0, 0, At, B0); PG8_BAR; PG8_SCHED;
            PG8_LDB(B1, 0, 1); PG8_STAGE(PG8_SB(0, 0), b2, voffB);
            PG8_BAR; PG8_WAIT_L(0); PG8_MMA(0, 1, At, B1); PG8_BAR;
            PG8_LDA(At, 0, 1); PG8_STAGE(PG8_SA(0, 0), a2, voffA);
            PG8_BAR; PG8_WAIT_L(0); PG8_MMA(1, 0, At, B0); PG8_BAR; PG8_SCHED;
            PG8_STAGE(PG8_SB(0, 1), b2 + hstep, voffB);
            PG8_WAIT_V(6); PG8_BAR; PG8_MMA(1, 1, At, B1); PG8_BAR;
            PG8_LDB(B0, 1, 0); PG8_SCHED; PG8_LDA(At, 1, 0); PG8_STAGE(PG8_SA(0, 1), a2 + hstep, voffA);
            PG8_WAIT_L(8); PG8_BAR; PG8_WAIT_L(0); PG8_MMA(0, 0, At, B0); PG8_BAR; PG8_SCHED;
            PG8_LDB(B1, 1, 1); PG8_STAGE(PG8_SB(1, 0), b3, voffB);
            PG8_BAR; PG8_WAIT_L(0); PG8_MMA(0, 1, At, B1); PG8_BAR;
            PG8_LDA(At, 1, 1); PG8_STAGE(PG8_SA(1, 0), a3, voffA);
            PG8_BAR; PG8_WAIT_L(0); PG8_MMA(1, 0, At, B0); PG8_BAR; PG8_SCHED;
            PG8_STAGE(PG8_SB(1, 1), b3 + hstep, voffB);
            PG8_WAIT_V(6); PG8_BAR; PG8_MMA(1, 1, At, B1); PG8_BAR;
            }
        }
        }
        if constexpr (ALIGN_EPI) { if (wr == 0) PG8_BAR; }
        if constexpr (!Epi::AFTER_DRAIN) { E(acc, cur, wr, wc, fr, fq); S.done(cur); }
        if (!has_next) break;
#pragma unroll
        for (int a = 0; a < 2; ++a)
#pragma unroll
            for (int b = 0; b < 2; ++b)
#pragma unroll
                for (int m = 0; m < 4; ++m)
#pragma unroll
                    for (int n = 0; n < 2; ++n) acc[a][b][m][n] = (f32x4){0.f, 0.f, 0.f, 0.f};
        cur = nxt; cA = nA; cB = nB; ++ui;
        if constexpr (ALIGN_EPI) { if (wr == 1) PG8_BAR; }
    }
    PG8_WAIT_V(0);
    if constexpr (!ALIGN_EPI) { if (wr == 0) PG8_BAR; }
    PG8_BAR;
    if constexpr (Epi::AFTER_DRAIN) { E.fused(acc, cur, wr, wc, fr, fq, lds, wid, lane); S.done(cur); }
#undef PG8_SA
#undef PG8_SB
#undef PG8_STAGE
#undef PG8_LDA
#undef PG8_LDB
#undef PG8_MMA
#undef PG8_WAIT_V
#undef PG8_WAIT_L
#undef PG8_BAR
#undef PG8_SCHED
}
}

namespace mk {
using pg8::bf16_t; using pg8::bf16x8; using pg8::f32x4; using pg8::cvt_pk_bf16;
#define LAS __attribute__((address_space(3)))
typedef float f32x16 __attribute__((ext_vector_type(16)));
typedef short v4i16 __attribute__((ext_vector_type(4)));
typedef unsigned u32x2 __attribute__((ext_vector_type(2)));
typedef unsigned u32x4 __attribute__((ext_vector_type(4)));

constexpr int BATCH = 32, SEQ = 2048, DM = 1024, NCHUNK = 2, BC = BATCH / NCHUNK, TC = BC * SEQ;
constexpr int PHW = 4352, NINP = 7680, DFF = 2816, NUP = 5632;
constexpr float LOG2E = 1.4426950408889634f;
constexpr size_t MiB = 1u << 20;
constexpr size_t WS_CTL = 0, CTL_BYTES = 32768, CTL_BAR = 4096;
constexpr size_t WS_W = 1 * MiB, LW = 40 * MiB;
constexpr size_t W_IN = 0, W_BR = 15 * MiB, W_O = 18 * MiB, W_UP = 20 * MiB, W_DN = 31 * MiB, W_1T = 37 * MiB, W_2T = 38 * MiB, W_B1 = 38 * MiB + 65536;
constexpr size_t WS_XN = 82 * MiB, WS_KC = 146 * MiB, WS_VC = 147 * MiB, WS_F = 148 * MiB, WS_HB = 150 * MiB  , WS_R = 214 * MiB;
constexpr size_t R_PH = 0, R_MG = 272 * MiB, R_GT = 464 * MiB, R_OA = 468 * MiB, R_OB = 500 * MiB, R_OC = 532 * MiB, R_MP = 0, R_UG = 0, R_ACT = 352 * MiB;
constexpr size_t WS_END = WS_R + 564 * MiB;
constexpr int L_KT = 0, L_VT = 18432, L_B1 = 36864  , L_MISC = 73728  , L_OX = 0  , L_SEL = 110592, L_UNI = L_SEL + 256, L_UQ = L_SEL + 512, L_FT = L_SEL + 1024  ;
constexpr int LDS_BYTES = 131072 + 1024;
constexpr int IMPS = 33;

struct Params { const float* in[22]; float* out; unsigned char* ws; int ph_lo, ph_hi; };

__device__ __forceinline__ float bf2f(unsigned short v) { return __uint_as_float(((unsigned)v) << 16); }
__device__ __forceinline__ float sigm(float x) { return __builtin_amdgcn_rcpf(1.0f + __builtin_amdgcn_exp2f(-1.4426950408889634f * x)); }
__device__ __forceinline__ float gelu_tanh(float x) { const float u = 0.7978845608028654f * (x + 0.044715f * x * x * x); return x * __builtin_amdgcn_rcpf(1.0f + __builtin_amdgcn_exp2f(-2.8853900817779268f * u)); }
__device__ __forceinline__ float ex2(float x) { return __builtin_amdgcn_exp2f(x); }
__device__ __forceinline__ f32x16 mfma32(bf16x8 a, bf16x8 b, f32x16 c) { return __builtin_amdgcn_mfma_f32_32x32x16_bf16(a, b, c, 0, 0, 0); }
__device__ __forceinline__ f32x4 mfma16(bf16x8 a, bf16x8 b, f32x4 c) { return __builtin_amdgcn_mfma_f32_16x16x32_bf16(a, b, c, 0, 0, 0); }
__device__ __forceinline__ bf16x8 vtr2(const LAS unsigned char* p, int step) {
    const v4i16 a = __builtin_amdgcn_ds_read_tr16_b64_v4i16((LAS v4i16*)p);
    const v4i16 b = __builtin_amdgcn_ds_read_tr16_b64_v4i16((LAS v4i16*)(p + step));
    return __builtin_shufflevector(a, b, 0, 1, 2, 3, 4, 5, 6, 7);
}
__device__ __forceinline__ bf16x8 pack8(float a0, float a1, float a2, float a3, float a4, float a5, float a6, float a7) {
    u32x4 w; w.x = cvt_pk_bf16(a0, a1); w.y = cvt_pk_bf16(a2, a3); w.z = cvt_pk_bf16(a4, a5); w.w = cvt_pk_bf16(a6, a7);
    return __builtin_bit_cast(bf16x8, w);
}
__device__ __forceinline__ float wave_sum(float v) {
#pragma unroll
    for (int o = 1; o < 64; o <<= 1) v += __shfl_xor(v, o);
    return v;
}

__device__ __forceinline__ int orig_in_col(int c) {
    if (c < 4352) { const int pn = c >> 8, l = c & 255, bj = l >> 7, wc = (l >> 5) & 3, j = l & 31; const int head = 4 * pn + wc, e = 32 * bj + j; return (head < 20 ? head * 64 : head * 64 + 24) + e; }
    if (c < 7424) return 4384 + (c - 4352);
    const int x = c - 7424; if (x < 24) return 1280 + x; if (x < 32) return 4376 + (x - 24); return -1;
}
template <int MODE>
__device__ __forceinline__ void transpose_mat(const float* src, int K, int Nsrc, bf16_t* dst, int Ndst, LAS float* tile, int tid, int ldd = 0) {
    if (ldd == 0) ldd = K;
    const int ntk = K / 64, nt = (Ndst / 64) * ntk;
    const int cc = tid & 63, kr = tid >> 6, c2 = tid >> 3, kc = (tid & 7) * 8;
    float nx[8];
    { const int it = blockIdx.x; if (it < nt) { const int tn = it / ntk, tk = it - tn * ntk; const int sc = MODE ? orig_in_col(tn * 64 + cc) : (tn * 64 + cc);
#pragma unroll
        for (int r = 0; r < 8; ++r) nx[r] = sc >= 0 ? src[(size_t)(tk * 64 + r * 8 + kr) * Nsrc + sc] : 0.f; } }
    for (int it = blockIdx.x; it < nt; it += gridDim.x) {
        const int tn = it / ntk, tk = it - tn * ntk, c0 = tn * 64, k0 = tk * 64;
        float cur[8];
#pragma unroll
        for (int r = 0; r < 8; ++r) cur[r] = nx[r];
        { const int it2 = it + gridDim.x; if (it2 < nt) { const int tn2 = it2 / ntk, tk2 = it2 - tn2 * ntk; const int sc2 = MODE ? orig_in_col(tn2 * 64 + cc) : (tn2 * 64 + cc);
#pragma unroll
            for (int r = 0; r < 8; ++r) nx[r] = sc2 >= 0 ? src[(size_t)(tk2 * 64 + r * 8 + kr) * Nsrc + sc2] : 0.f; } }
#pragma unroll
        for (int r = 0; r < 8; ++r) tile[(r * 8 + kr) * 65 + cc] = cur[r];
        asm volatile("s_waitcnt lgkmcnt(0)" ::: "memory"); __builtin_amdgcn_s_barrier(); asm volatile("" ::: "memory");
        float v[8];
#pragma unroll
        for (int i = 0; i < 8; ++i) v[i] = tile[(kc + i) * 65 + c2];
        u32x4 w; w.x = cvt_pk_bf16(v[0], v[1]); w.y = cvt_pk_bf16(v[2], v[3]); w.z = cvt_pk_bf16(v[4], v[5]); w.w = cvt_pk_bf16(v[6], v[7]);
        *(u32x4*)(dst + (size_t)(c0 + c2) * ldd + k0 + kc) = w;
        asm volatile("s_waitcnt lgkmcnt(0)" ::: "memory"); __builtin_amdgcn_s_barrier(); asm volatile("" ::: "memory");
    }
}
__device__ __forceinline__ void p0_prologue(const Params& p, LAS unsigned char* lds, int tid) {
    LAS float* tile = (LAS float*)lds;
    if (blockIdx.x < 4) {
        const int l = blockIdx.x >> 1, kv = blockIdx.x & 1, n = tid & 127, part = tid >> 7;
        const float* pe = p.in[5] + (size_t)(l * 2 + kv) * 2048; const float* w1 = p.in[6] + (size_t)(l * 2 + kv) * 2048 * 128;
        float s = 0.f;
        for (int k = part * 512; k < part * 512 + 512; ++k) s += pe[k] * w1[(size_t)k * 128 + n];
        tile[part * 128 + n] = s;
        __syncthreads();
        if (tid < 128) { float* b1 = (float*)(p.ws + WS_W + l * LW + W_B1); b1[kv * 128 + tid] = (tile[tid] + tile[128 + tid]) + (tile[256 + tid] + tile[384 + tid]); }
        __syncthreads();
    }
    for (int l = 0; l < 2; ++l) {
        unsigned char* wb = p.ws + WS_W + l * LW;
        transpose_mat<1>(p.in[2] + (size_t)l * 1024 * 7456, 1024, 7456, (bf16_t*)(wb + W_IN), NINP, tile, tid);
        for (int i = 0; i < 3; ++i) transpose_mat<0>(p.in[15] + (size_t)(l * 3 + i) * 512 * 1024, 512, 1024, (bf16_t*)(wb + W_BR) + (size_t)i * 512, 1024, tile, tid, 1536);
        transpose_mat<0>(p.in[16] + (size_t)l * 1024 * 1024, 1024, 1024, (bf16_t*)(wb + W_O), 1024, tile, tid);
        transpose_mat<0>(p.in[18] + (size_t)l * 1024 * NUP, 1024, NUP, (bf16_t*)(wb + W_UP), NUP, tile, tid);
        transpose_mat<0>(p.in[21] + (size_t)l * DFF * 1024, DFF, 1024, (bf16_t*)(wb + W_DN), 1024, tile, tid);
        for (int kv = 0; kv < 2; ++kv) {
            transpose_mat<0>(p.in[6] + (size_t)(l * 2 + kv) * 2048 * 128, 2048, 128, (bf16_t*)(wb + W_1T) + (size_t)kv * 128 * 2048, 128, tile, tid);
            transpose_mat<0>(p.in[7] + (size_t)(l * 2 + kv) * 128 * 64, 128, 64, (bf16_t*)(wb + W_2T) + (size_t)kv * 64 * 128, 64, tile, tid);
        }
    }
}

template <bool SRC_BF16>
__device__ __forceinline__ void norm_phase(const void* srcv, const float* g, bf16_t* XN, int wid, int lane) {
    f32x4 gv[4];
#pragma unroll
    for (int i = 0; i < 4; ++i) gv[i] = *(const f32x4*)(g + 4 * (lane + 64 * i));
    for (int row0 = (blockIdx.x * 8 + wid) * 4; row0 < TC; row0 += gridDim.x * 8 * 4) {
        f32x4 v[4][4]; float ss[4];
#pragma unroll
        for (int r = 0; r < 4; ++r)
#pragma unroll
            for (int i = 0; i < 4; ++i) {
                if (SRC_BF16) { const u32x2 w = *(const u32x2*)((const bf16_t*)srcv + (size_t)(row0 + r) * 1024 + 4 * (lane + 64 * i));
                    v[r][i][0] = __uint_as_float(w.x << 16); v[r][i][1] = __uint_as_float(w.x & 0xffff0000u); v[r][i][2] = __uint_as_float(w.y << 16); v[r][i][3] = __uint_as_float(w.y & 0xffff0000u); }
                else v[r][i] = *(const f32x4*)((const float*)srcv + (size_t)(row0 + r) * 1024 + 4 * (lane + 64 * i)); }
#pragma unroll
        for (int r = 0; r < 4; ++r) { float s = 0.f;
#pragma unroll
            for (int i = 0; i < 4; ++i) s += (v[r][i][0] * v[r][i][0] + v[r][i][1] * v[r][i][1]) + (v[r][i][2] * v[r][i][2] + v[r][i][3] * v[r][i][3]);
            ss[r] = wave_sum(s); }
#pragma unroll
        for (int r = 0; r < 4; ++r) { const float rr = rsqrtf(ss[r] * (1.0f / 1024.0f) + 1e-6f);
#pragma unroll
            for (int i = 0; i < 4; ++i) { const f32x4 o = v[r][i] * rr * gv[i]; u32x2 w; w.x = cvt_pk_bf16(o[0], o[1]); w.y = cvt_pk_bf16(o[2], o[3]); *(u32x2*)(XN + (size_t)(row0 + r) * 1024 + 4 * (lane + 64 * i)) = w; } }
    }
}

__device__ __forceinline__ void prep_phase(const Params& p, LAS unsigned char* lds, int layer, int wid, int lane) {
    unsigned char* ws = p.ws; unsigned char* wb = ws + WS_W + layer * LW;
    const bf16_t* PH = (const bf16_t*)(ws + WS_R + R_PH);
    const float* GT = (const float*)(ws + WS_R + R_GT);
    const int l16 = lane & 15, G = lane >> 4, grp = wid >> 2, wq = wid & 3;
    for (int wu0 = blockIdx.x * 2; wu0 < 512; wu0 += gridDim.x * 2) {
        const int wu = wu0 + grp;
        const int nt = wu & 7, kv = (wu >> 3) & 1, g = (wu >> 4) & 1, b = wu >> 5;
        const int n = nt * 16 + l16; const int nn = n < 127 ? n : 126;
        const bf16_t* w1t = (const bf16_t*)(wb + W_1T) + (size_t)kv * 128 * 2048;
        const bf16_t* w2t = (const bf16_t*)(wb + W_2T) + (size_t)kv * 64 * 128;
        const float* b1 = (const float*)(wb + W_B1) + kv * 128;
        const bf16_t* src = PH + (size_t)(b * SEQ + 16 * nn) * PHW + (8 + kv * 2 + g) * 64 + 8 * G;
        const bf16_t* wa = w1t + (size_t)l16 * 2048 + 8 * G;
        f32x4 acc[8];
#pragma unroll
        for (int mt = 0; mt < 8; ++mt) acc[mt] = (f32x4){0.f, 0.f, 0.f, 0.f};
        for (int ks0 = wq * 16; ks0 < wq * 16 + 16; ks0 += 4) {
            bf16x8 bfr[4], afr[4][8];
#pragma unroll
            for (int q = 0; q < 4; ++q) { const int ks = ks0 + q; bfr[q] = *(const bf16x8*)(src + (size_t)(ks >> 1) * PHW + (ks & 1) * 32);
#pragma unroll
                for (int mt = 0; mt < 8; ++mt) afr[q][mt] = *(const bf16x8*)(wa + (size_t)mt * 16 * 2048 + ks * 32); }
#pragma unroll
            for (int q = 0; q < 4; ++q)
#pragma unroll
                for (int mt = 0; mt < 8; ++mt) acc[mt] = mfma16(afr[q][mt], bfr[q], acc[mt]);
        }
        LAS f32x4* red = (LAS f32x4*)(lds + (grp * 3) * 8192);
        if (wq > 0) {
#pragma unroll
            for (int mt = 0; mt < 8; ++mt) red[(wq - 1) * 512 + mt * 64 + lane] = acc[mt];
        }
        __syncthreads();
        if (wq == 0) {
#pragma unroll
            for (int mt = 0; mt < 8; ++mt) acc[mt] = ((acc[mt] + red[mt * 64 + lane]) + red[512 + mt * 64 + lane]) + red[1024 + mt * 64 + lane];
#pragma unroll
            for (int mt = 0; mt < 8; ++mt) { const f32x4 bb = *(const f32x4*)(b1 + 16 * mt + 4 * G);
#pragma unroll
                for (int j = 0; j < 4; ++j) acc[mt][j] = gelu_tanh(acc[mt][j] + bb[j]); }
            f32x4 oc[4];
#pragma unroll
            for (int dt = 0; dt < 4; ++dt) oc[dt] = (f32x4){0.f, 0.f, 0.f, 0.f};
#pragma unroll
            for (int s = 0; s < 4; ++s) {
                const bf16x8 bfr = pack8(acc[2 * s][0], acc[2 * s][1], acc[2 * s][2], acc[2 * s][3], acc[2 * s + 1][0], acc[2 * s + 1][1], acc[2 * s + 1][2], acc[2 * s + 1][3]);
#pragma unroll
                for (int dt = 0; dt < 4; ++dt) {
                    const bf16_t* ap = w2t + (size_t)(16 * dt + l16) * 128 + 32 * s + 4 * G;
                    const u32x2 lo = *(const u32x2*)ap, hi = *(const u32x2*)(ap + 16);
                    u32x4 w; w.x = lo.x; w.y = lo.y; w.z = hi.x; w.w = hi.y;
                    oc[dt] = mfma16(__builtin_bit_cast(bf16x8, w), bfr, oc[dt]);
                }
            }
            if (kv == 0) {
                float ss = 0.f;
#pragma unroll
                for (int dt = 0; dt < 4; ++dt) ss += (oc[dt][0] * oc[dt][0] + oc[dt][1] * oc[dt][1]) + (oc[dt][2] * oc[dt][2] + oc[dt][3] * oc[dt][3]);
                ss += __shfl_xor(ss, 16); ss += __shfl_xor(ss, 32);
                const float r = rsqrtf(ss * (1.0f / 64.0f) + 1e-6f);
                const float* kg = p.in[4] + (size_t)layer * 192;
#pragma unroll
                for (int dt = 0; dt < 4; ++dt) { const f32x4 gg = *(const f32x4*)(kg + 16 * dt + 4 * G); oc[dt] = oc[dt] * r * gg; }
            }
            bf16_t* dst = (bf16_t*)(ws + (kv ? WS_VC : WS_KC)) + ((size_t)(b * 2 + g) * 128 + n) * 64 + 4 * G;
            const bool live = n < 127;
#pragma unroll
            for (int dt = 0; dt < 4; ++dt) { u32x2 w; w.x = live ? cvt_pk_bf16(oc[dt][0], oc[dt][1]) : 0u; w.y = live ? cvt_pk_bf16(oc[dt][2], oc[dt][3]) : 0u; *(u32x2*)(dst + 16 * dt) = w; }
        } else if (wq == 1 && wu < 128) {
            const int bh = wu, bb_ = bh >> 3, h = bh & 7;
            const float fb = p.in[14][layer * 8 + h];
            const float* gp = GT + (size_t)(bb_ * SEQ + 32 * lane) * 32 + 24 + h;
            float v[32]; float run = 0.f;
#pragma unroll
            for (int i = 0; i < 32; ++i) { const float x = gp[(size_t)i * 32] + fb; const float lsg = fminf(x, 0.f) - log1pf(__expf(-fabsf(x))); run += lsg; v[i] = run; }
            float incl = run;
#pragma unroll
            for (int o = 1; o < 64; o <<= 1) { const float t_ = __shfl_up(incl, o); if (lane >= o) incl += t_; }
            const float excl = incl - run;
            float* fo = (float*)(ws + WS_F) + (size_t)bh * SEQ + 32 * lane;
#pragma unroll
            for (int i = 0; i < 32; i += 4) *(f32x4*)(fo + i) = (f32x4){v[i] + excl, v[i + 1] + excl, v[i + 2] + excl, v[i + 3] + excl} * (-LOG2E);
        }
        __syncthreads();
    }
}

typedef float f32x2_t __attribute__((ext_vector_type(2))); typedef __bf16 bf16x2_t __attribute__((ext_vector_type(2)));
__device__ __forceinline__ unsigned cvtpk(float lo, float hi) { const f32x2_t v = {lo, hi}; const bf16x2_t r = __builtin_convertvector(v, bf16x2_t); return __builtin_bit_cast(unsigned, r); }
__device__ __forceinline__ bf16x8 pack8n(float a0, float a1, float a2, float a3, float a4, float a5, float a6, float a7) {
    u32x4 w; w.x = cvtpk(a0, a1); w.y = cvtpk(a2, a3); w.z = cvtpk(a4, a5); w.w = cvtpk(a6, a7);
    return __builtin_bit_cast(bf16x8, w);
}
constexpr float QKB = 16.0f;
template <bool FOX, int DV>
__device__ __forceinline__ void attn_tile64(bool MASKED, const LAS unsigned char* Kt, int krow, const LAS unsigned char* Vt, int vrow, const bf16x8 (&qf)[4], f32x16 (&o)[DV / 32], f32x16& lacc,
                                            int lane, int tpos, int kbase, float slope2, float rowc, bool rowsel, int win, const LAS float* Ft) {
    __builtin_amdgcn_sched_barrier(0);
    const int l32 = lane & 31, g = lane >> 5;
    f32x16 s[2];
    if (FOX) {
#pragma unroll
        for (int kb = 0; kb < 2; ++kb)
#pragma unroll
            for (int a = 0; a < 4; ++a) { const f32x4 f = *(const LAS f32x4*)(Ft + 32 * kb + 8 * a + 4 * g); s[kb][4 * a] = f[0] - rowc; s[kb][4 * a + 1] = f[1] - rowc; s[kb][4 * a + 2] = f[2] - rowc; s[kb][4 * a + 3] = f[3] - rowc; }
    } else {
        const float base = slope2 * (float)(kbase + 4 * g - tpos) - QKB;
#pragma unroll
        for (int kb = 0; kb < 2; ++kb)
#pragma unroll
            for (int j = 0; j < 16; ++j) s[kb][j] = fmaf(slope2, (float)(32 * kb + 8 * (j >> 2) + (j & 3)), base);
    }
#pragma unroll
    for (int kb = 0; kb < 2; ++kb)
#pragma unroll
        for (int ks = 0; ks < 4; ++ks) { const bf16x8 a = *(const LAS bf16x8*)(Kt + (32 * kb + l32) * krow + (16 * ks + 8 * g) * 2); s[kb] = mfma32(a, qf[ks], s[kb]); }
    if (MASKED) {
        const int rel = tpos - kbase - 4 * g;
#pragma unroll
        for (int kb = 0; kb < 2; ++kb)
#pragma unroll
            for (int j = 0; j < 16; ++j) { const int c = 32 * kb + 8 * (j >> 2) + (j & 3); const bool ok = rowsel && (c <= rel) && (rel - c < win); s[kb][j] = ok ? s[kb][j] : -1e30f; }
    }
#pragma unroll
    for (int kb = 0; kb < 2; ++kb)
#pragma unroll
        for (int j = 0; j < 16; ++j) s[kb][j] = ex2(s[kb][j]);
    bf16x8 pb[2][2];
#pragma unroll
    for (int kb = 0; kb < 2; ++kb)
#pragma unroll
        for (int kk = 0; kk < 2; ++kk) pb[kb][kk] = pack8n(s[kb][8 * kk], s[kb][8 * kk + 1], s[kb][8 * kk + 2], s[kb][8 * kk + 3], s[kb][8 * kk + 4], s[kb][8 * kk + 5], s[kb][8 * kk + 6], s[kb][8 * kk + 7]);
    const LAS unsigned char* vb = Vt + (4 * g + ((lane & 15) >> 2)) * vrow + (16 * ((lane >> 4) & 1) + 4 * (lane & 3)) * 2;
    const bf16x8 ones = (bf16x8){0x3F80, 0x3F80, 0x3F80, 0x3F80, 0x3F80, 0x3F80, 0x3F80, 0x3F80};
#pragma unroll
    for (int kb = 0; kb < 2; ++kb)
#pragma unroll
        for (int kk = 0; kk < 2; ++kk) lacc = mfma32(ones, pb[kb][kk], lacc);
#pragma unroll
    for (int dt = 0; dt < DV / 32; ++dt) {
#pragma unroll
        for (int kb = 0; kb < 2; ++kb)
#pragma unroll
            for (int kk = 0; kk < 2; ++kk) { const bf16x8 a = vtr2(vb + (32 * kb + 16 * kk) * vrow + 64 * dt, 8 * vrow); o[dt] = mfma32(a, pb[kb][kk], o[dt]); }
        }
    __builtin_amdgcn_sched_barrier(0);
}

__device__ __forceinline__ void zero16(f32x16& v) {
#pragma unroll
    for (int j = 0; j < 16; ++j) v[j] = 0.f;
}

__device__ __forceinline__ void fox_unit(const Params& p, LAS unsigned char* lds, int b, int h, int qb, int tid, int wid, int lane) {
    unsigned char* ws = p.ws;
    const bf16_t* PH = (const bf16_t*)(ws + WS_R + R_PH); bf16_t* OC = (bf16_t*)(ws + WS_R + R_OA) + 1024;
    const float* nF2 = (const float*)(ws + WS_F) + (size_t)(b * 8 + h) * SEQ;
    const int l32 = lane & 31, g = lane >> 5, tokbase = b * SEQ;
    const int q0 = 256 * qb + 32 * wid, tpos = q0 + l32;
    bf16x8 qf[4];
#pragma unroll
    for (int ks = 0; ks < 4; ++ks) qf[ks] = *(const bf16x8*)(PH + (size_t)(tokbase + tpos) * PHW + (44 + h) * 64 + 16 * ks + 8 * g);
    f32x16 o[2], lacc; zero16(o[0]); zero16(o[1]); zero16(lacc);
    const float rowc = nF2[tpos] + QKB;
    const int ntiles = 4 * qb + 4, srow = tid >> 3, sch = tid & 7;
    const bf16_t* kg = PH + (size_t)(tokbase + srow) * PHW + (52 + h) * 64 + sch * 8;
    const bf16_t* vg = PH + (size_t)(tokbase + srow) * PHW + (60 + h) * 64 + sch * 8;
    u32x4 kA, vA, kB, vB; f32x4 fA, fB;
    { const int n_ = ntiles;
      kA = *(const u32x4*)(kg + (size_t)(0) * 64 * PHW); vA = *(const u32x4*)(vg + (size_t)(0) * 64 * PHW); fA = *(const f32x4*)(nF2 + (0) * 64 + 4 * (tid & 15)); if (n_ > 1) { kB = *(const u32x4*)(kg + (size_t)(1) * 64 * PHW); vB = *(const u32x4*)(vg + (size_t)(1) * 64 * PHW); fB = *(const f32x4*)(nF2 + (1) * 64 + 4 * (tid & 15)); }
      *(LAS u32x4*)(lds + 0 + L_KT + srow * 144 + sch * 16) = kA; *(LAS u32x4*)(lds + 0 + L_VT + srow * 192 + sch * 16) = vA; if (tid < 16) *(LAS f32x4*)(lds + L_FT + 0 * 256 + tid * 16) = fA; if (n_ > 2) { kA = *(const u32x4*)(kg + (size_t)(2) * 64 * PHW); vA = *(const u32x4*)(vg + (size_t)(2) * 64 * PHW); fA = *(const f32x4*)(nF2 + (2) * 64 + 4 * (tid & 15)); }
      __syncthreads();
#pragma unroll 1
      for (int i_ = 0; i_ < n_; i_ += 2) {
        if (i_ + 1 < n_) { *(LAS u32x4*)(lds + L_B1 + L_KT + srow * 144 + sch * 16) = kB; *(LAS u32x4*)(lds + L_B1 + L_VT + srow * 192 + sch * 16) = vB; if (tid < 16) *(LAS f32x4*)(lds + L_FT + 1 * 256 + tid * 16) = fB; if (i_ + 3 < n_) { kB = *(const u32x4*)(kg + (size_t)((i_ + 3)) * 64 * PHW); vB = *(const u32x4*)(vg + (size_t)((i_ + 3)) * 64 * PHW); fB = *(const f32x4*)(nF2 + ((i_ + 3)) * 64 + 4 * (tid & 15)); } }
        if (64 * i_ <= q0 + 31) attn_tile64<true, 64>(64 * i_ + 63 > q0, lds + 0 + L_KT, 144, lds + 0 + L_VT, 192, qf, o, lacc, lane, tpos, 64 * i_, 0.f, rowc, true, 1 << 30, (const LAS float*)(lds + L_FT + 0 * 256));
        __syncthreads();
        if (i_ + 1 < n_) {
          if (i_ + 2 < n_) { *(LAS u32x4*)(lds + 0 + L_KT + srow * 144 + sch * 16) = kA; *(LAS u32x4*)(lds + 0 + L_VT + srow * 192 + sch * 16) = vA; if (tid < 16) *(LAS f32x4*)(lds + L_FT + 0 * 256 + tid * 16) = fA; if (i_ + 4 < n_) { kA = *(const u32x4*)(kg + (size_t)((i_ + 4)) * 64 * PHW); vA = *(const u32x4*)(vg + (size_t)((i_ + 4)) * 64 * PHW); fA = *(const f32x4*)(nF2 + ((i_ + 4)) * 64 + 4 * (tid & 15)); } }
          if (64 * (i_ + 1) <= q0 + 31) attn_tile64<true, 64>(64 * (i_ + 1) + 63 > q0, lds + L_B1 + L_KT, 144, lds + L_B1 + L_VT, 192, qf, o, lacc, lane, tpos, 64 * (i_ + 1), 0.f, rowc, true, 1 << 30, (const LAS float*)(lds + L_FT + 1 * 256));
          __syncthreads();
        }
      }
    }
    const float inv = 1.0f / lacc[0];
    bf16_t* op = OC + (size_t)(tokbase + tpos) * 1536 + h * 64 + 4 * g;
#pragma unroll
    for (int dt = 0; dt < 2; ++dt)
#pragma unroll
        for (int a = 0; a < 4; ++a) { u32x2 w; w.x = cvt_pk_bf16(o[dt][4 * a] * inv, o[dt][4 * a + 1] * inv); w.y = cvt_pk_bf16(o[dt][4 * a + 2] * inv, o[dt][4 * a + 3] * inv); *(u32x2*)(op + 32 * dt + 8 * a) = w; }
}

__device__ __forceinline__ void diff_unit(const Params& p, LAS unsigned char* lds, int layer, int b, int h, int qt, int tid, int wid, int lane) {
    unsigned char* ws = p.ws;
    const bf16_t* PH = (const bf16_t*)(ws + WS_R + R_PH); bf16_t* OB = (bf16_t*)(ws + WS_R + R_OA) + 512;
    const int l32 = lane & 31, g = lane >> 5, tokbase = b * SEQ, c = wid >> 2, wq = wid & 3;
    const int q0 = 128 * qt + 32 * wq, tpos = q0 + l32;
    const float* lv = p.in[10] + (size_t)layer * 256;
    const float lam_init = 0.8f - 0.6f * __expf(-0.3f * (float)layer);
    const float lam = __expf(wave_sum(lv[lane] * lv[64 + lane])) - __expf(wave_sum(lv[128 + lane] * lv[192 + lane])) + lam_init;
    bf16x8 qf[4];
#pragma unroll
    for (int ks = 0; ks < 4; ++ks) qf[ks] = *(const bf16x8*)(PH + (size_t)(tokbase + tpos) * PHW + (20 + 2 * h + c) * 64 + 16 * ks + 8 * g);
    const float slope2 = ex2(-2.0f * (float)(h + 1)) * LOG2E;
    f32x16 o[4], lacc; zero16(o[0]); zero16(o[1]); zero16(o[2]); zero16(o[3]); zero16(lacc);
    const int ntiles = 2 * qt + 2;
    const int r0 = tid >> 4, ch = tid & 15;
    const bf16_t* kg = PH + (size_t)(tokbase + r0) * PHW + (28 + 2 * h) * 64 + ch * 8;
    const bf16_t* vg = PH + (size_t)(tokbase + r0) * PHW + (36 + 2 * h) * 64 + ch * 8;
    u32x4 kA0, kA1, vA0, vA1, kB0, kB1, vB0, vB1;
    { const int n_ = ntiles;
      { const size_t off = (size_t)(0) * 64 * PHW; kA0 = *(const u32x4*)(kg + off); kA1 = *(const u32x4*)(kg + off + (size_t)32 * PHW); vA0 = *(const u32x4*)(vg + off); vA1 = *(const u32x4*)(vg + off + (size_t)32 * PHW); } if (n_ > 1) { { const size_t off = (size_t)(1) * 64 * PHW; kB0 = *(const u32x4*)(kg + off); kB1 = *(const u32x4*)(kg + off + (size_t)32 * PHW); vB0 = *(const u32x4*)(vg + off); vB1 = *(const u32x4*)(vg + off + (size_t)32 * PHW); } }
      *(LAS u32x4*)(lds + 0 + L_KT + r0 * 272 + ch * 16) = kA0; *(LAS u32x4*)(lds + 0 + L_KT + (r0 + 32) * 272 + ch * 16) = kA1; *(LAS u32x4*)(lds + 0 + 17408 + r0 * 320 + ch * 16) = vA0; *(LAS u32x4*)(lds + 0 + 17408 + (r0 + 32) * 320 + ch * 16) = vA1; if (n_ > 2) { { const size_t off = (size_t)(2) * 64 * PHW; kA0 = *(const u32x4*)(kg + off); kA1 = *(const u32x4*)(kg + off + (size_t)32 * PHW); vA0 = *(const u32x4*)(vg + off); vA1 = *(const u32x4*)(vg + off + (size_t)32 * PHW); } }
      __syncthreads();
#pragma unroll 1
      for (int i_ = 0; i_ < n_; i_ += 2) {
        if (i_ + 1 < n_) { *(LAS u32x4*)(lds + 40960 + L_KT + r0 * 272 + ch * 16) = kB0; *(LAS u32x4*)(lds + 40960 + L_KT + (r0 + 32) * 272 + ch * 16) = kB1; *(LAS u32x4*)(lds + 40960 + 17408 + r0 * 320 + ch * 16) = vB0; *(LAS u32x4*)(lds + 40960 + 17408 + (r0 + 32) * 320 + ch * 16) = vB1; if (i_ + 3 < n_) { { const size_t off = (size_t)((i_ + 3)) * 64 * PHW; kB0 = *(const u32x4*)(kg + off); kB1 = *(const u32x4*)(kg + off + (size_t)32 * PHW); vB0 = *(const u32x4*)(vg + off); vB1 = *(const u32x4*)(vg + off + (size_t)32 * PHW); } } }
        if (64 * i_ <= q0 + 31) attn_tile64<false, 128>(64 * i_ + 63 > q0, lds + 0 + L_KT + c * 128, 272, lds + 0 + 17408, 320, qf, o, lacc, lane, tpos, 64 * i_, slope2, 0.f, true, 1 << 30, nullptr);
        __syncthreads();
        if (i_ + 1 < n_) {
          if (i_ + 2 < n_) { *(LAS u32x4*)(lds + 0 + L_KT + r0 * 272 + ch * 16) = kA0; *(LAS u32x4*)(lds + 0 + L_KT + (r0 + 32) * 272 + ch * 16) = kA1; *(LAS u32x4*)(lds + 0 + 17408 + r0 * 320 + ch * 16) = vA0; *(LAS u32x4*)(lds + 0 + 17408 + (r0 + 32) * 320 + ch * 16) = vA1; if (i_ + 4 < n_) { { const size_t off = (size_t)((i_ + 4)) * 64 * PHW; kA0 = *(const u32x4*)(kg + off); kA1 = *(const u32x4*)(kg + off + (size_t)32 * PHW); vA0 = *(const u32x4*)(vg + off); vA1 = *(const u32x4*)(vg + off + (size_t)32 * PHW); } } }
          if (64 * (i_ + 1) <= q0 + 31) attn_tile64<false, 128>(64 * (i_ + 1) + 63 > q0, lds + 40960 + L_KT + c * 128, 272, lds + 40960 + 17408, 320, qf, o, lacc, lane, tpos, 64 * (i_ + 1), slope2, 0.f, true, 1 << 30, nullptr);
          __syncthreads();
        }
      }
    }
    const float inv = 1.0f / lacc[0];
    LAS float* OX = (LAS float*)(lds + L_OX);
    const int ql = 32 * wq + l32;
    if (c == 1) {
        const float f = inv * lam;
#pragma unroll
        for (int dt = 0; dt < 4; ++dt)
#pragma unroll
            for (int j = 0; j < 16; ++j) { const int d = 32 * dt + 8 * (j >> 2) + 4 * g + (j & 3); OX[d * 128 + ql] = o[dt][j] * f; }
    }
    __syncthreads();
    if (c == 0) {
        float ss = 0.f;
#pragma unroll
        for (int dt = 0; dt < 4; ++dt)
#pragma unroll
            for (int j = 0; j < 16; ++j) { const int d = 32 * dt + 8 * (j >> 2) + 4 * g + (j & 3); const float v = o[dt][j] * inv - OX[d * 128 + ql]; o[dt][j] = v; ss += v * v; }
        ss += __shfl_xor(ss, 32);
        const float r = rsqrtf(ss * (1.0f / 128.0f) + 1e-6f) * (1.0f - lam_init);
        const float* sg = p.in[11] + (size_t)layer * 128;
        bf16_t* op = OB + (size_t)(tokbase + tpos) * 1536 + h * 128 + 4 * g;
#pragma unroll
        for (int dt = 0; dt < 4; ++dt)
#pragma unroll
            for (int a = 0; a < 4; ++a) { const f32x4 gg = *(const f32x4*)(sg + 32 * dt + 8 * a + 4 * g);
                u32x2 w; w.x = cvt_pk_bf16(o[dt][4 * a] * r * gg[0], o[dt][4 * a + 1] * r * gg[1]); w.y = cvt_pk_bf16(o[dt][4 * a + 2] * r * gg[2], o[dt][4 * a + 3] * r * gg[3]); *(u32x2*)(op + 32 * dt + 8 * a) = w; }
    }
}

__device__ __forceinline__ void nsa_unit(const Params& p, LAS unsigned char* lds, int b, int gq, int tq, int tid, int wid, int lane) {
    unsigned char* ws = p.ws;
    const bf16_t* PH = (const bf16_t*)(ws + WS_R + R_PH); bf16_t* OA = (bf16_t*)(ws + WS_R + R_OA);
    const float* GT = (const float*)(ws + WS_R + R_GT);
    const int l32 = lane & 31, g = lane >> 5, tokbase = b * SEQ, r = wid >> 1, th = wid & 1, head = gq * 4 + r;
    const int t0 = 64 * tq, tl = 32 * th + l32, tpos = t0 + tl;
    const float slope2 = ex2(-(float)(head + 1)) * LOG2E;
    bf16x8 qf[4];
#pragma unroll
    for (int ks = 0; ks < 4; ++ks) qf[ks] = *(const bf16x8*)(PH + (size_t)(tokbase + tpos) * PHW + head * 64 + 16 * ks + 8 * g);
    const float* gtp = GT + (size_t)(tokbase + tpos) * 32 + head;
    const float gc = sigm(gtp[0]), gs = sigm(gtp[8]), gw = sigm(gtp[16]);
    const int srow = tid >> 3, sch = tid & 7, j0 = tq >= 4 ? tq - 4 : 0;
    const u32x4 kS0 = *(const u32x4*)(PH + (size_t)(tokbase + srow) * PHW + (12 + gq) * 64 + sch * 8), vS0 = *(const u32x4*)(PH + (size_t)(tokbase + srow) * PHW + (14 + gq) * 64 + sch * 8);
    const u32x4 kW0 = *(const u32x4*)(PH + (size_t)(tokbase + j0 * 64 + srow) * PHW + (16 + gq) * 64 + sch * 8), vW0 = *(const u32x4*)(PH + (size_t)(tokbase + j0 * 64 + srow) * PHW + (18 + gq) * 64 + sch * 8);
    f32x16 tot[2];
    LAS float* IMP = (LAS float*)(lds + L_MISC);
    LAS unsigned* SEL = (LAS unsigned*)(lds + L_SEL);
    {
        const bf16_t* kc = (const bf16_t*)(ws + WS_KC) + (size_t)(b * 2 + gq) * 128 * 64;
        const bf16_t* vc = (const bf16_t*)(ws + WS_VC) + (size_t)(b * 2 + gq) * 128 * 64;
        __syncthreads();
#pragma unroll
        for (int i = 0; i < 2; ++i) { const int idx = tid + 512 * i, row = idx >> 3, ch = idx & 7;
            *(LAS u32x4*)(lds + L_KT + row * 144 + ch * 16) = *(const u32x4*)(kc + row * 64 + ch * 8);
            *(LAS u32x4*)(lds + L_VT + row * 192 + ch * 16) = *(const u32x4*)(vc + row * 64 + ch * 8); }
        __syncthreads();
        f32x16 s[4];
#pragma unroll
        for (int kb = 0; kb < 4; ++kb) { zero16(s[kb]);
#pragma unroll
            for (int ks = 0; ks < 4; ++ks) { const bf16x8 a = *(const LAS bf16x8*)(lds + L_KT + (32 * kb + l32) * 144 + (16 * ks + 8 * g) * 2); s[kb] = mfma32(a, qf[ks], s[kb]); } }
        float mx = -1e30f;
#pragma unroll
        for (int kb = 0; kb < 4; ++kb)
#pragma unroll
            for (int j = 0; j < 16; ++j) { const int n = 32 * kb + 8 * (j >> 2) + 4 * g + (j & 3); const int dist = tpos - (16 * n + 31);
                const float v = dist >= 0 ? s[kb][j] + slope2 * (float)(16 * n) : -1e30f; s[kb][j] = v; mx = fmaxf(mx, v); }
        mx = fmaxf(mx, __shfl_xor(mx, 32));
        float psum = 0.f;
#pragma unroll
        for (int kb = 0; kb < 4; ++kb)
#pragma unroll
            for (int j = 0; j < 16; ++j) { const float pv = s[kb][j] > -1e29f ? ex2(s[kb][j] - mx) : 0.f; s[kb][j] = pv; psum += pv; }
        psum += __shfl_xor(psum, 32);
        const float invl = psum > 0.f ? 1.0f / psum : 0.f;
#pragma unroll
        for (int kb = 0; kb < 4; ++kb) s[kb] *= invl;
        float prevrecv = 0.f;
#pragma unroll
        for (int kb = 0; kb < 4; ++kb)
#pragma unroll
            for (int a = 0; a < 4; ++a) {
                const float run = (s[kb][4 * a] + s[kb][4 * a + 1]) + (s[kb][4 * a + 2] + s[kb][4 * a + 3]);
                const float recv = __shfl_xor(s[kb][4 * a + 3], 32);
                const float val = run + (g ? recv : prevrecv);
                prevrecv = recv;
                IMP[(r * 64 + tl) * IMPS + 8 * kb + 2 * a + g] = val;
            }
        zero16(tot[0]); zero16(tot[1]);
        const LAS unsigned char* vb = lds + L_VT + (4 * g + ((lane & 15) >> 2)) * 192 + (16 * ((lane >> 4) & 1) + 4 * (lane & 3)) * 2;
#pragma unroll
        for (int kb = 0; kb < 4; ++kb)
#pragma unroll
            for (int kk = 0; kk < 2; ++kk) {
                const bf16x8 pb = pack8(s[kb][8 * kk], s[kb][8 * kk + 1], s[kb][8 * kk + 2], s[kb][8 * kk + 3], s[kb][8 * kk + 4], s[kb][8 * kk + 5], s[kb][8 * kk + 6], s[kb][8 * kk + 7]);
#pragma unroll
                for (int dt = 0; dt < 2; ++dt) { const bf16x8 a = vtr2(vb + (32 * kb + 16 * kk) * 192 + 64 * dt, 8 * 192); tot[dt] = mfma32(a, pb, tot[dt]); }
            }
        tot[0] *= gc; tot[1] *= gc;
    }
    __syncthreads();
    if (wid == 0) {
        float sc[32];
#pragma unroll
        for (int j = 0; j < 32; ++j) {
            const float imp = ((IMP[(0 * 64 + lane) * IMPS + j] + IMP[(1 * 64 + lane) * IMPS + j]) + IMP[(2 * 64 + lane) * IMPS + j]) + IMP[(3 * 64 + lane) * IMPS + j];
            const bool forced = (j == 0) || (j == tq) || (j == tq - 1);
            sc[j] = j <= tq ? (forced ? imp + 1.0e4f : imp) : -1e30f;
            if ((j & 3) == 3) __builtin_amdgcn_sched_barrier(0);
        }
        unsigned mask = 0u;
        for (int k = 0; k < 8; ++k) {
            float best = -3.0e38f; int idx = 0;
#pragma unroll
            for (int j = 0; j < 32; ++j) { const float v = ((mask >> j) & 1u) ? -3.0e38f : sc[j]; if (v > best) { best = v; idx = j; } }
            mask |= 1u << idx;
        }
        mask &= (tq == 31) ? 0xffffffffu : ((2u << tq) - 1u);
        SEL[lane] = mask;
        unsigned un = mask;
#pragma unroll
        for (int o = 1; o < 64; o <<= 1) un |= (unsigned)__shfl_xor((int)un, o);
        if (lane == 0) { SEL[64] = un; int c = 0; for (unsigned r_ = un; r_; r_ &= r_ - 1u) { ((LAS int*)(lds + L_SEL + 272))[c] = __ffs((int)r_) - 1; ++c; } *(LAS int*)(lds + L_SEL + 268) = c; }
    }
    __syncthreads();
    const unsigned uni = (unsigned)__builtin_amdgcn_readfirstlane((int)SEL[64]);
    const unsigned mysel = SEL[tl];
    {
        f32x16 o[2], lacc; zero16(o[0]); zero16(o[1]); zero16(lacc);
        const bf16_t* kg = PH + (size_t)(tokbase + srow) * PHW + (12 + gq) * 64 + sch * 8;
        const bf16_t* vg = PH + (size_t)(tokbase + srow) * PHW + (14 + gq) * 64 + sch * 8;
        u32x4 kA, vA, kB, vB;
        const LAS int* LIST = (const LAS int*)(lds + L_SEL + 272);
        { const int n_ = __builtin_amdgcn_readfirstlane(*(const LAS int*)(lds + L_SEL + 268));
          kA = kS0; vA = vS0; if (n_ > 1) { { const int bk_ = __builtin_amdgcn_readfirstlane(LIST[1]); kB = *(const u32x4*)(kg + (size_t)bk_ * 64 * PHW); vB = *(const u32x4*)(vg + (size_t)bk_ * 64 * PHW); } }
          *(LAS u32x4*)(lds + 0 + L_KT + srow * 144 + sch * 16) = kA; *(LAS u32x4*)(lds + 0 + L_VT + srow * 192 + sch * 16) = vA; if (n_ > 2) { { const int bk_ = __builtin_amdgcn_readfirstlane(LIST[2]); kA = *(const u32x4*)(kg + (size_t)bk_ * 64 * PHW); vA = *(const u32x4*)(vg + (size_t)bk_ * 64 * PHW); } }
          __syncthreads();
#pragma unroll 1
          for (int i_ = 0; i_ < n_; i_ += 2) {
            if (i_ + 1 < n_) { *(LAS u32x4*)(lds + L_B1 + L_KT + srow * 144 + sch * 16) = kB; *(LAS u32x4*)(lds + L_B1 + L_VT + srow * 192 + sch * 16) = vB; if (i_ + 3 < n_) { { const int bk_ = __builtin_amdgcn_readfirstlane(LIST[(i_ + 3)]); kB = *(const u32x4*)(kg + (size_t)bk_ * 64 * PHW); vB = *(const u32x4*)(vg + (size_t)bk_ * 64 * PHW); } } }
            { const int j = __builtin_amdgcn_readfirstlane(LIST[i_]); const bool rs = ((mysel >> j) & 1u) != 0u; attn_tile64<false, 64>(j == tq || __builtin_amdgcn_ballot_w64(rs) != ~0ull, lds + 0 + L_KT, 144, lds + 0 + L_VT, 192, qf, o, lacc, lane, tpos, 64 * j, slope2, 0.f, rs, 1 << 30, nullptr); }
            __syncthreads();
            if (i_ + 1 < n_) {
              if (i_ + 2 < n_) { *(LAS u32x4*)(lds + 0 + L_KT + srow * 144 + sch * 16) = kA; *(LAS u32x4*)(lds + 0 + L_VT + srow * 192 + sch * 16) = vA; if (i_ + 4 < n_) { { const int bk_ = __builtin_amdgcn_readfirstlane(LIST[(i_ + 4)]); kA = *(const u32x4*)(kg + (size_t)bk_ * 64 * PHW); vA = *(const u32x4*)(vg + (size_t)bk_ * 64 * PHW); } } }
              { const int j = __builtin_amdgcn_readfirstlane(LIST[(i_ + 1)]); const bool rs = ((mysel >> j) & 1u) != 0u; attn_tile64<false, 64>(j == tq || __builtin_amdgcn_ballot_w64(rs) != ~0ull, lds + L_B1 + L_KT, 144, lds + L_B1 + L_VT, 192, qf, o, lacc, lane, tpos, 64 * j, slope2, 0.f, rs, 1 << 30, nullptr); }
              __syncthreads();
            }
          }
        }
        const float lt = lacc[0], f = lt > 0.f ? gs / lt : 0.f;
        tot[0] += o[0] * f; tot[1] += o[1] * f;
    }
    {
        f32x16 o[2], lacc; zero16(o[0]); zero16(o[1]); zero16(lacc);
        const bf16_t* kg = PH + (size_t)(tokbase + srow) * PHW + (16 + gq) * 64 + sch * 8;
        const bf16_t* vg = PH + (size_t)(tokbase + srow) * PHW + (18 + gq) * 64 + sch * 8;
        u32x4 kA, vA, kB, vB;
        { const int n_ = tq - j0 + 1;
          kA = kW0; vA = vW0; if (n_ > 1) { kB = *(const u32x4*)(kg + (size_t)(j0 + 1) * 64 * PHW); vB = *(const u32x4*)(vg + (size_t)(j0 + 1) * 64 * PHW); }
          *(LAS u32x4*)(lds + 0 + L_KT + srow * 144 + sch * 16) = kA; *(LAS u32x4*)(lds + 0 + L_VT + srow * 192 + sch * 16) = vA; if (n_ > 2) { kA = *(const u32x4*)(kg + (size_t)(j0 + 2) * 64 * PHW); vA = *(const u32x4*)(vg + (size_t)(j0 + 2) * 64 * PHW); }
          __syncthreads();
#pragma unroll 1
          for (int i_ = 0; i_ < n_; i_ += 2) {
            if (i_ + 1 < n_) { *(LAS u32x4*)(lds + L_B1 + L_KT + srow * 144 + sch * 16) = kB; *(LAS u32x4*)(lds + L_B1 + L_VT + srow * 192 + sch * 16) = vB; if (i_ + 3 < n_) { kB = *(const u32x4*)(kg + (size_t)(j0 + (i_ + 3)) * 64 * PHW); vB = *(const u32x4*)(vg + (size_t)(j0 + (i_ + 3)) * 64 * PHW); } }
            { const int j = j0 + i_; attn_tile64<false, 64>(j == tq || j == tq - 4, lds + 0 + L_KT, 144, lds + 0 + L_VT, 192, qf, o, lacc, lane, tpos, 64 * j, slope2, 0.f, true, 256, nullptr); }
            __syncthreads();
            if (i_ + 1 < n_) {
              if (i_ + 2 < n_) { *(LAS u32x4*)(lds + 0 + L_KT + srow * 144 + sch * 16) = kA; *(LAS u32x4*)(lds + 0 + L_VT + srow * 192 + sch * 16) = vA; if (i_ + 4 < n_) { kA = *(const u32x4*)(kg + (size_t)(j0 + (i_ + 4)) * 64 * PHW); vA = *(const u32x4*)(vg + (size_t)(j0 + (i_ + 4)) * 64 * PHW); } }
              { const int j = j0 + (i_ + 1); attn_tile64<false, 64>(j == tq || j == tq - 4, lds + L_B1 + L_KT, 144, lds + L_B1 + L_VT, 192, qf, o, lacc, lane, tpos, 64 * j, slope2, 0.f, true, 256, nullptr); }
              __syncthreads();
            }
          }
        }
        const float lt = lacc[0], f = lt > 0.f ? gw / lt : 0.f;
        tot[0] += o[0] * f; tot[1] += o[1] * f;
    }
    bf16_t* op = OA + (size_t)(tokbase + tpos) * 1536 + head * 64 + 4 * g;
#pragma unroll
    for (int dt = 0; dt < 2; ++dt)
#pragma unroll
        for (int a = 0; a < 4; ++a) { u32x2 w; w.x = cvt_pk_bf16(tot[dt][4 * a], tot[dt][4 * a + 1]); w.y = cvt_pk_bf16(tot[dt][4 * a + 2], tot[dt][4 * a + 3]); *(u32x2*)(op + 32 * dt + 8 * a) = w; }
}

#ifndef ATT_REP_TYPES
#define ATT_REP_TYPES 7
#endif
#ifndef ATT_REPS
#define ATT_REPS 1
#endif
__device__ __forceinline__ void attn_phase(const Params& p, LAS unsigned char* lds, int layer, unsigned* ctr, int tid_in, int tmask = 7) {
    LAS int* uq = (LAS int*)(lds + L_UQ);
    for (;;) {
        __syncthreads();
        if (tid_in == 0) *uq = (int)atomicAdd(ctr, 1u);
        __syncthreads();
        const int u_ = __builtin_amdgcn_readfirstlane(*uq);
        if (u_ >= 3072 * ATT_REPS) break;
        const int u = u_ % 3072; if (u_ >= 3072) tmask = ATT_REP_TYPES;
        int tid = tid_in; asm volatile("" : "+v"(tid));
        const int lane = tid & 63, wid = __builtin_amdgcn_readfirstlane(tid >> 6);
        const int lv = u / 192, idx = u - lv * 192;
        if (idx < 64) { if (tmask & 1) diff_unit(p, lds, layer, idx >> 2, idx & 3, 15 - lv, tid, wid, lane); }
        else if (idx < 128) { const int k = (idx - 64) + 64 * (lv & 1); if (tmask & 2) fox_unit(p, lds, k >> 3, k & 7, 7 - (lv >> 1), tid, wid, lane); }
        else { const int k = idx - 128; if (tmask & 4) nsa_unit(p, lds, k >> 2, (k >> 1) & 1, 31 - 2 * lv - (k & 1), tid, wid, lane); }
    }
}

__device__ __forceinline__ void unpack8(const u32x4 w, float (&x)[8]) {
#pragma unroll
    for (int i = 0; i < 4; ++i) { x[2 * i] = __uint_as_float(w[i] << 16); x[2 * i + 1] = __uint_as_float(w[i] & 0xffff0000u); }
}
__device__ __forceinline__ void conv_phase(const Params& p, int layer, int tid) {
    const bf16_t* UG = (const bf16_t*)(p.ws + WS_R + R_UG); bf16_t* ACT = (bf16_t*)(p.ws + WS_R + R_ACT);
    const float* cw = p.in[19] + (size_t)layer * 3 * DFF; const float* cb = p.in[20] + (size_t)layer * DFF;
    constexpr int NCG = DFF / 8, RUN = 32, NITEM = (TC / RUN) * NCG;
    for (int it = blockIdx.x * 512 + tid; it < NITEM; it += gridDim.x * 512) {
        const int run = it / NCG, c = (it - run * NCG) * 8, t0 = run * RUN;
        float w0[8], w1[8], w2[8], bb[8];
#pragma unroll
        for (int hf = 0; hf < 2; ++hf) { const f32x4 a = *(const f32x4*)(cw + c + 4 * hf), b2 = *(const f32x4*)(cw + DFF + c + 4 * hf), c2 = *(const f32x4*)(cw + 2 * DFF + c + 4 * hf), d = *(const f32x4*)(cb + c + 4 * hf);
#pragma unroll
            for (int i = 0; i < 4; ++i) { w0[4 * hf + i] = a[i]; w1[4 * hf + i] = b2[i]; w2[4 * hf + i] = c2[i]; bb[4 * hf + i] = d[i]; } }
        const bf16_t* up = UG + (size_t)t0 * NUP + c;
        float x0[8], x1[8];
        const bool head = (t0 & (SEQ - 1)) == 0;
        { u32x4 a = (u32x4){0u, 0u, 0u, 0u}, b2 = a; if (!head) { a = *(const u32x4*)(up - 2 * NUP); b2 = *(const u32x4*)(up - NUP); } unpack8(a, x0); unpack8(b2, x1); }
#pragma unroll 1
        for (int r0 = 0; r0 < RUN; r0 += 4) {
            u32x4 uw[4], gw[4];
#pragma unroll
            for (int q = 0; q < 4; ++q) { uw[q] = *(const u32x4*)(up + (size_t)(r0 + q) * NUP); gw[q] = *(const u32x4*)(up + (size_t)(r0 + q) * NUP + DFF); }
#pragma unroll
            for (int q = 0; q < 4; ++q) {
                float x2[8], xg[8], res[8]; unpack8(uw[q], x2); unpack8(gw[q], xg);
#pragma unroll
                for (int i = 0; i < 8; ++i) { res[i] = gelu_tanh(bb[i] + w0[i] * x0[i] + w1[i] * x1[i] + w2[i] * x2[i]) * xg[i]; x0[i] = x1[i]; x1[i] = x2[i]; }
                u32x4 w; w.x = cvt_pk_bf16(res[0], res[1]); w.y = cvt_pk_bf16(res[2], res[3]); w.z = cvt_pk_bf16(res[4], res[5]); w.w = cvt_pk_bf16(res[6], res[7]);
                *(u32x4*)(ACT + (size_t)(t0 + r0 + q) * DFF + c) = w;
            }
        }
    }
}

#define XB_TMO      128
#define XB_XCNT(j)  (256  + 64 * (j))
#define XB_XSUB(j)  (1280 + 64 * (j))
#define XB_XGEN(j)  (2304 + 64 * (j))
#define XB_TOP      3328
#define XB_TOPGEN   3392
#define XCD_BAR_WORDS 3456
#define XB_SPIN_CAP (1u << 18)

__device__ __forceinline__ unsigned xb_ld(unsigned* p)              { return __hip_atomic_load(p, __ATOMIC_RELAXED, __HIP_MEMORY_SCOPE_AGENT); }
__device__ __forceinline__ unsigned xb_add(unsigned* p, unsigned v) { return __hip_atomic_fetch_add(p, v, __ATOMIC_RELAXED, __HIP_MEMORY_SCOPE_AGENT); }
__device__ __forceinline__ unsigned xb_xcc_id() { return (unsigned)__builtin_amdgcn_s_getreg((3 << 11) | 20) & 0xFu; }
#define XB_SPIN(cond, bar) do { unsigned _sp = 0; while (cond) { __builtin_amdgcn_s_sleep(1); \
    if ((++_sp & 255u) == 0u) { if (xb_ld(&(bar)[XB_TMO])) break; if (_sp > XB_SPIN_CAP) { atomicAdd(&(bar)[XB_TMO], 1u); break; } } } } while (0)

struct XcdBarrier {
    unsigned* bar; unsigned x;
    volatile LAS unsigned* st;
};

__device__ __forceinline__ XcdBarrier xcd_barrier_post(unsigned* bar, volatile LAS unsigned* st) {
    XcdBarrier b; b.bar = bar; b.x = xb_xcc_id(); b.st = st;
    if (threadIdx.x == 0) (void)xb_add(&bar[XB_XCNT(b.x)], 1u);
    return b;
}
__device__ __forceinline__ void xcd_barrier_complete(unsigned* bar, unsigned x, unsigned& nloc, unsigned& nx) {
    const unsigned G = gridDim.x * gridDim.y * gridDim.z;
    unsigned sum, cnt, mine, sp = 0u;
    for (;;) {
        sum = 0u; cnt = 0u; mine = 0u;
#pragma unroll
        for (unsigned j = 0; j < 16; ++j) { const unsigned c = xb_ld(&bar[XB_XCNT(j)]); sum += c; cnt += (c > 0u) ? 1u : 0u; mine = (j == x) ? c : mine; }
        if (sum == G) break;
        __builtin_amdgcn_s_sleep(1);
        if ((++sp & 255u) == 0u) { if (xb_ld(&bar[XB_TMO])) break; if (sp > XB_SPIN_CAP) { atomicAdd(&bar[XB_TMO], 1u); break; } }
    }
    nloc = mine > 0u ? mine : 1u; nx = cnt > 0u ? cnt : 1u;
}

__device__ __forceinline__ void xcd_barrier(const XcdBarrier& b) {
    asm volatile("s_waitcnt vmcnt(0)" ::: "memory");
    __syncthreads();
    if (threadIdx.x == 0) {
        unsigned* bar = b.bar;
        __builtin_amdgcn_s_waitcnt(0);
        unsigned nloc = b.st[0], nx = b.st[1];
        if (nloc == 0u) { xcd_barrier_complete(bar, b.x, nloc, nx); b.st[0] = nloc; b.st[1] = nx; }
        const unsigned old = xb_add(&bar[XB_XSUB(b.x)], 1u);
        const unsigned gen = old / nloc;
        if (old + 1u == (gen + 1u) * nloc) {
            __builtin_amdgcn_fence(__ATOMIC_RELEASE, "agent");
            asm volatile("s_waitcnt vmcnt(0)" ::: "memory");
            const unsigned og = xb_add(&bar[XB_TOP], 1u);
            const unsigned tg = og / nx;
            if (og + 1u == (tg + 1u) * nx) xb_add(&bar[XB_TOPGEN], 1u);
            else XB_SPIN(xb_ld(&bar[XB_TOPGEN]) == tg, bar);
            __builtin_amdgcn_fence(__ATOMIC_ACQUIRE, "agent");
            xb_add(&bar[XB_XGEN(b.x)], 1u);
            asm volatile("s_waitcnt vmcnt(0)" ::: "memory");
        } else {
            XB_SPIN(xb_ld(&bar[XB_XGEN(b.x)]) == gen, bar);
            __builtin_amdgcn_fence(__ATOMIC_ACQUIRE, "agent");
            asm volatile("s_waitcnt vmcnt(0)" ::: "memory");
        }
    }
    __syncthreads();
}

constexpr int NPH = 1 + NCHUNK * 2 * 10;
#ifndef PH_MASK
#define PH_MASK 0xfff
#endif
#define EN(k) ((PH_MASK >> (k)) & 1)
#ifndef REP_MASK
#define REP_MASK 0
#endif

#ifndef GEMM_SP2
#define GEMM_SP2 true
#endif
#ifndef GEMM_ALIGN
#define GEMM_ALIGN true
#endif

__global__ void __launch_bounds__(512) fwd_megakernel(Params p) {
    extern __shared__ __attribute__((aligned(16))) unsigned char smem[];
    LAS unsigned char* lds = (LAS unsigned char*)smem;
    cg::grid_group grid = cg::this_grid();
    volatile LAS unsigned* xst = (volatile LAS unsigned*)(lds + 131072 + 512);
    if (threadIdx.x < 2) xst[threadIdx.x] = 0u;
    __syncthreads();
    const XcdBarrier xbar = xcd_barrier_post((unsigned*)(p.ws + WS_CTL + CTL_BAR), xst);
    for (int ph = p.ph_lo; ph < p.ph_hi; ++ph) {
        int tid0 = threadIdx.x; asm volatile("" : "+v"(tid0));
        unsigned char* ws = p.ws; asm volatile("" : "+s"(ws));
        if (ph == 0) { if (EN(10)) p0_prologue(p, lds, tid0); }
        else {
            const int q = ph - 1, chunk = q / 20, layer = (q / 10) & 1, k = q % 10;
            unsigned char* wb = ws + WS_W + layer * LW;
            bf16_t* XN = (bf16_t*)(ws + WS_XN);
            float* fout = p.out + (size_t)chunk * TC * DM; const float* xin = p.in[0] + (size_t)chunk * TC * DM; bf16_t* HB = (bf16_t*)(ws + WS_HB);
            pg8::StaticOrder S;
            for (int rep = 0; rep <= ((REP_MASK >> k) & 1); ++rep) {
            if (rep) xcd_barrier(xbar);
            int tid = tid0; asm volatile("" : "+v"(tid));
            const int lane = tid & 63, wid = __builtin_amdgcn_readfirstlane(tid >> 6);
            if (k == 0) { if (EN(0)) { if (layer == 0) norm_phase<false>(xin, p.in[1], XN, wid, lane); else norm_phase<true>(HB, p.in[1] + DM, XN, wid, lane); } }
            else if (k == 1) { if (EN(1)) {
                pg8::Gemm g{XN, (const bf16_t*)(wb + W_IN), TC, NINP, 1024}; S.init(TC, NINP, gridDim.x, blockIdx.x);
                pg8::EpiIn E{(bf16_t*)(ws + WS_R + R_PH), (bf16_t*)(ws + WS_R + R_MG), (float*)(ws + WS_R + R_GT), p.in[3] + layer * 64, p.in[4] + layer * 192, p.in[8] + layer * 64, p.in[9] + layer * 64, p.in[12] + layer * 64, p.in[13] + layer * 64};
                pg8::gemm_phase<pg8::EpiIn, pg8::StaticOrder, GEMM_ALIGN, GEMM_SP2>(lds, g, S, E); }
            }
            else if (k == 2) { if (EN(2)) prep_phase(p, lds, layer, wid, lane); }
            else if (k == 3) { if (EN(3)) attn_phase(p, lds, layer, (unsigned*)(ws + WS_CTL) + 16 * (chunk * 2 + layer) + 8 * rep, tid, 7); }
            else if (k == 4) { if (EN(4)) {
                S.init(TC, 1024, gridDim.x, blockIdx.x);
                pg8::Gemm g{(const bf16_t*)(ws + WS_R + R_OA), (const bf16_t*)(wb + W_BR), TC, 1024, 1536};
                pg8::EpiMerge E{(const bf16_t*)(ws + WS_R + R_MG), XN}; pg8::gemm_phase<pg8::EpiMerge, pg8::StaticOrder, GEMM_ALIGN, GEMM_SP2>(lds, g, S, E); }
            }
            else if (k == 5) { if (EN(5)) {
                pg8::Gemm g{XN, (const bf16_t*)(wb + W_O), TC, 1024, 1024}; S.init(TC, 1024, gridDim.x, blockIdx.x);
                if (layer == 0) { pg8::EpiRes<false, true> E{xin, HB}; pg8::gemm_phase<pg8::EpiRes<false, true>, pg8::StaticOrder, GEMM_ALIGN, GEMM_SP2>(lds, g, S, E); }
                else { pg8::EpiRes<true, true> E{HB, HB}; pg8::gemm_phase<pg8::EpiRes<true, true>, pg8::StaticOrder, GEMM_ALIGN, GEMM_SP2>(lds, g, S, E); } }
            }
            else if (k == 6) { if (EN(6)) norm_phase<true>(HB, p.in[17] + layer * DM, XN, wid, lane); }
            else if (k == 7) { if (EN(7)) {
                pg8::Gemm g{XN, (const bf16_t*)(wb + W_UP), TC, NUP, 1024}; S.init(TC, NUP, gridDim.x, blockIdx.x);
                pg8::EpiStore E{(bf16_t*)(ws + WS_R + R_UG), NUP}; pg8::gemm_phase<pg8::EpiStore, pg8::StaticOrder, GEMM_ALIGN, GEMM_SP2>(lds, g, S, E); }
            }
            else if (k == 8) { if (EN(8)) conv_phase(p, layer, tid); }
            else { if (EN(9)) {
                pg8::Gemm g{(const bf16_t*)(ws + WS_R + R_ACT), (const bf16_t*)(wb + W_DN), TC, 1024, DFF}; S.init(TC, 1024, gridDim.x, blockIdx.x);
                if (layer == 0) { pg8::EpiRes<true, true> E{HB, HB}; pg8::gemm_phase<pg8::EpiRes<true, true>, pg8::StaticOrder, GEMM_ALIGN, GEMM_SP2>(lds, g, S, E); }
                else { pg8::EpiRes<true, false> E{HB, fout}; pg8::gemm_phase<pg8::EpiRes<true, false>, pg8::StaticOrder, GEMM_ALIGN, GEMM_SP2>(lds, g, S, E); } }
            }
            }
        }
        if (ph + 1 < p.ph_hi) { if (p.ph_lo < 0) grid.sync(); else xcd_barrier(xbar); }
    }
}
}

extern "C" void kernel_launch(void* const* d_in, const int* in_sizes, int n_in, void* d_out, int out_size, void* d_ws, size_t ws_size, hipStream_t stream) {
    static int grid = 0;
    if (grid == 0) {
        if (n_in != 22 || ws_size < mk::WS_END) { fprintf(stderr, "kernel_launch: unexpected n_in %d or ws %zu (< %zu)\n", n_in, ws_size, (size_t)mk::WS_END); grid = -1; return; }
        int dev = 0, cus = 0, per_cu = 0;
        hipGetDevice(&dev); hipDeviceGetAttribute(&cus, hipDeviceAttributeMultiprocessorCount, dev);
        if (hipFuncSetAttribute((const void*)mk::fwd_megakernel, hipFuncAttributeMaxDynamicSharedMemorySize, mk::LDS_BYTES) != hipSuccess) { fprintf(stderr, "hipFuncSetAttribute failed\n"); grid = -1; return; }
        if (hipOccupancyMaxActiveBlocksPerMultiprocessor(&per_cu, (const void*)mk::fwd_megakernel, 512, mk::LDS_BYTES) != hipSuccess || per_cu < 1) { fprintf(stderr, "occupancy query: %d\n", per_cu); per_cu = 1; }
        (void)hipGetLastError();
        grid = cus * per_cu;
    }
    if (grid < 0) return;
    hipMemsetAsync((char*)d_ws + mk::WS_CTL, 0, mk::CTL_BYTES, stream);
    mk::Params p{};
    for (int i = 0; i < 22; ++i) p.in[i] = (const float*)d_in[i];
    p.out = (float*)d_out; p.ws = (unsigned char*)d_ws; p.ph_lo = 0; p.ph_hi = mk::NPH;
    void* args[] = {&p};
    hipError_t e = hipLaunchCooperativeKernel((void*)mk::fwd_megakernel, dim3(grid), dim3(512), args, mk::LDS_BYTES, stream);
    if (e != hipSuccess) fprintf(stderr, "cooperative launch failed: %s (grid %d)\n", hipGetErrorString(e), grid);
}
```

```cpp
#include <hip/hip_runtime.h>
#include <hip/hip_cooperative_groups.h>
#include <cstdio>
#include <cstdint>
namespace cg = cooperative_groups;
namespace pg8 {
#define PG8_LAS __attribute__((address_space(3)))
typedef unsigned short bf16_t;
typedef short bf16x8 __attribute__((ext_vector_type(8)));
typedef float f32x4 __attribute__((ext_vector_type(4)));
typedef unsigned u32x4 __attribute__((ext_vector_type(4)));
constexpr int BM = 256, BK = 64, HALF = 128, HTB = HALF * BK * 2  , STAGE_BYTES = 8 * HTB, NXCD = 8, WGM = 8;

__host__ __device__ __forceinline__ int lds_byte(int r, int c) { const int st = (r >> 4) * 2 + (c >> 5), rr = r & 15, cc = c & 31, ob = rr * 64 + cc * 2; return st * 1024 + (ob ^ (((ob >> 9) & 1) << 5)); }
__host__ __device__ __forceinline__ void stage_rc(int b, int& R, int& C) { const int st = b / 1024, sb = b % 1024, swz = sb ^ (((sb >> 9) & 1) << 5); R = (st >> 1) * 16 + swz / 64; C = (st & 1) * 32 + (swz % 64) / 2; }
__host__ __device__ __forceinline__ int perm32(int rho) { const int n = rho >> 4, i = rho & 15; return 8 * (i >> 2) + 4 * n + (i & 3); }

struct Unit { int pm, pn; };
struct Gemm { const bf16_t* A; const bf16_t* Bt; int M, N, K; };

struct StaticOrder {
    int nM, nN, nwg, G, c;
    __host__ __device__ void init(int M, int N, int G_, int c_) { nM = M / BM; nN = N / BM; nwg = nM * nN; G = G_; c = c_; }
    __host__ __device__ bool next(int i, Unit& u) const {
        const long L = (long)i * G + c; if (L >= nwg) return false;
        int wgid = (int)L; { const int q = nwg / NXCD, r = nwg % NXCD, xcd = wgid % NXCD, off = wgid / NXCD; wgid = (xcd < r ? xcd * (q + 1) : r * (q + 1) + (xcd - r) * q) + off; }
        const int nig = WGM * nN, gid = wgid / nig, fm = gid * WGM, gsz = (nM - fm) < WGM ? (nM - fm) : WGM;
        u.pm = fm + ((wgid % nig) % gsz); u.pn = (wgid % nig) / gsz; return true;
    }
    __device__ __forceinline__ void a_ready(const Unit&) const {}
    __device__ __forceinline__ void done(const Unit&) const {}
};
typedef float f32x2c_t __attribute__((ext_vector_type(2))); typedef __bf16 bf16x2c_t __attribute__((ext_vector_type(2)));
__device__ __forceinline__ unsigned cvt_pk_bf16(float lo, float hi) { const f32x2c_t v = {lo, hi}; const bf16x2c_t r = __builtin_convertvector(v, bf16x2c_t); return __builtin_bit_cast(unsigned, r); }
typedef unsigned u32x2 __attribute__((ext_vector_type(2)));
__device__ __forceinline__ float sigmoidf_(float x) { return __builtin_amdgcn_rcpf(1.0f + __builtin_amdgcn_exp2f(-1.4426950408889634f * x)); }
__device__ __forceinline__ float bf2f_(unsigned short v) { return __uint_as_float(((unsigned)v) << 16); }

struct EpiIn {
    static constexpr bool PERM = true, AFTER_DRAIN = false, HOOK = false;
    bf16_t* PH; bf16_t* MG; float* GT;
    const float *nsa_q_g, *nsa_k_g, *diff_q_g, *diff_k_g, *fox_q_g, *fox_k_g;
    __device__ __forceinline__ void operator()(const f32x4 (&acc)[2][2][4][2], const Unit& u, int wr, int wc, int fr, int fq) const {
        const int row0 = u.pm * BM + wr * 64 + fr;
        if (u.pn < 17) {
            const int head = 4 * u.pn + wc;
            const float* gp = nullptr; float sc = 1.0f;
            if (head < 8) { gp = nsa_q_g; sc = 0.125f * 1.4426950408889634f; }
            else if (head < 20) { const int hh = head - 8, br = hh >> 2, kv = (hh >> 1) & 1; if (kv == 0 && br >= 1) gp = nsa_k_g + br * 64; }
            else if (head < 28) { gp = diff_q_g; sc = 0.125f * 1.4426950408889634f; }
            else if (head < 36) { gp = diff_k_g; }
            else if (head < 44) { }
            else if (head < 52) { gp = fox_q_g; sc = 0.125f * 1.4426950408889634f; }
            else if (head < 60) { gp = fox_k_g; }
            f32x4 gv[2][2];
#pragma unroll
            for (int bj = 0; bj < 2; ++bj)
#pragma unroll
                for (int n = 0; n < 2; ++n) gv[bj][n] = gp ? *(const f32x4*)(gp + 32 * bj + 8 * fq + 4 * n) : (f32x4){1.f, 1.f, 1.f, 1.f};
#pragma unroll
            for (int ai = 0; ai < 2; ++ai)
#pragma unroll
                for (int m = 0; m < 4; ++m) {
                    float r = 1.0f;
                    if (gp) {
                        float ss = 0.f;
#pragma unroll
                        for (int bj = 0; bj < 2; ++bj)
#pragma unroll
                            for (int n = 0; n < 2; ++n) { const f32x4 x = acc[ai][bj][m][n]; ss += (x[0] * x[0] + x[1] * x[1]) + (x[2] * x[2] + x[3] * x[3]); }
                        ss += __shfl_xor(ss, 16); ss += __shfl_xor(ss, 32);
                        r = rsqrtf(ss * (1.0f / 64.0f) + 1e-6f) * sc;
                    }
                    bf16_t* rowp = PH + (size_t)(row0 + ai * HALF + m * 16) * 4352 + head * 64 + 8 * fq;
#pragma unroll
                    for (int bj = 0; bj < 2; ++bj) { const f32x4 v0 = acc[ai][bj][m][0] * r * gv[bj][0], v1 = acc[ai][bj][m][1] * r * gv[bj][1];
                        u32x4 w; w.x = cvt_pk_bf16(v0[0], v0[1]); w.y = cvt_pk_bf16(v0[2], v0[3]); w.z = cvt_pk_bf16(v1[0], v1[1]); w.w = cvt_pk_bf16(v1[2], v1[3]); *(u32x4*)(rowp + 32 * bj) = w; }
                }
        } else if (u.pn < 29) {
            const int col0 = (u.pn - 17) * BM + wc * 32 + 8 * fq;
#pragma unroll
            for (int ai = 0; ai < 2; ++ai)
#pragma unroll
                for (int m = 0; m < 4; ++m) {
                    bf16_t* rowp = MG + (size_t)(row0 + ai * HALF + m * 16) * 3072 + col0;
#pragma unroll
                    for (int bj = 0; bj < 2; ++bj) { const f32x4 v0 = acc[ai][bj][m][0], v1 = acc[ai][bj][m][1];
                        u32x4 w; w.x = cvt_pk_bf16(sigmoidf_(v0[0]), sigmoidf_(v0[1])); w.y = cvt_pk_bf16(sigmoidf_(v0[2]), sigmoidf_(v0[3])); w.z = cvt_pk_bf16(sigmoidf_(v1[0]), sigmoidf_(v1[1])); w.w = cvt_pk_bf16(sigmoidf_(v1[2]), sigmoidf_(v1[3]));
                        *(u32x4*)(rowp + bj * HALF) = w; }
                }
        } else {
            if (wc == 0) {
#pragma unroll
                for (int ai = 0; ai < 2; ++ai)
#pragma unroll
                    for (int m = 0; m < 4; ++m) {
                        float* rowp = GT + (size_t)(row0 + ai * HALF + m * 16) * 32 + 8 * fq;
#pragma unroll
                        for (int n = 0; n < 2; ++n) *(f32x4*)(rowp + 4 * n) = acc[ai][0][m][n];
                    }
            }
        }
    }
};

struct EpiMerge {
    static constexpr bool PERM = true, AFTER_DRAIN = false, HOOK = true;
    const bf16_t* MG; bf16_t* XN;
    __device__ __forceinline__ void gate8(const bf16_t* p, f32x4& g0, f32x4& g1) const {
        const u32x4 w = *(const u32x4*)p;
        g0[0] = __uint_as_float(w.x << 16); g0[1] = __uint_as_float(w.x & 0xffff0000u); g0[2] = __uint_as_float(w.y << 16); g0[3] = __uint_as_float(w.y & 0xffff0000u);
        g1[0] = __uint_as_float(w.z << 16); g1[1] = __uint_as_float(w.z & 0xffff0000u); g1[2] = __uint_as_float(w.w << 16); g1[3] = __uint_as_float(w.w & 0xffff0000u);
    }
    __device__ __forceinline__ void cvt8(const u32x4 w, f32x4& g0, f32x4& g1) const {
        g0[0] = __uint_as_float(w.x << 16); g0[1] = __uint_as_float(w.x & 0xffff0000u); g0[2] = __uint_as_float(w.y << 16); g0[3] = __uint_as_float(w.y & 0xffff0000u);
        g1[0] = __uint_as_float(w.z << 16); g1[1] = __uint_as_float(w.z & 0xffff0000u); g1[2] = __uint_as_float(w.w << 16); g1[3] = __uint_as_float(w.w & 0xffff0000u);
    }
    __device__ __forceinline__ void hook(f32x4 (&acc)[2][2][4][2], const Unit& u, int seg, int wr, int wc, int fr_, int fq_) const {
        int fr = fr_, fq = fq_; asm volatile("" : "+v"(fr), "+v"(fq));
        const int row0 = u.pm * BM + wr * 64 + fr, col0 = u.pn * BM + wc * 32 + 8 * fq;
#pragma unroll
        for (int ai = 0; ai < 2; ++ai) {
            u32x4 wa[4][2], wb[4][2];
#pragma unroll
            for (int m = 0; m < 4; ++m) {
                const bf16_t* gp = MG + (size_t)(row0 + ai * HALF + m * 16) * 3072 + (seg - 1) * 1024 + col0;
#pragma unroll
                for (int bj = 0; bj < 2; ++bj) { wa[m][bj] = *(const u32x4*)(gp + bj * HALF); wb[m][bj] = *(const u32x4*)(gp + 1024 + bj * HALF); }
            }
            __builtin_amdgcn_sched_barrier(0);
#pragma unroll
            for (int m = 0; m < 4; ++m)
#pragma unroll
                for (int bj = 0; bj < 2; ++bj) {
                    f32x4 a0, a1, b0, b1; cvt8(wa[m][bj], a0, a1); cvt8(wb[m][bj], b0, b1);
#pragma unroll
                    for (int i = 0; i < 4; ++i) { acc[ai][bj][m][0][i] *= a0[i] * __builtin_amdgcn_rcpf(b0[i]); acc[ai][bj][m][1][i] *= a1[i] * __builtin_amdgcn_rcpf(b1[i]); }
                }
            __builtin_amdgcn_sched_barrier(0);
        }
    }
    __device__ __forceinline__ void operator()(const f32x4 (&acc)[2][2][4][2], const Unit& u, int wr, int wc, int fr, int fq) const {
        const int row0 = u.pm * BM + wr * 64 + fr, col0 = u.pn * BM + wc * 32 + 8 * fq;
#pragma unroll
        for (int ai = 0; ai < 2; ++ai) {
            u32x4 wg[4][2];
#pragma unroll
            for (int m = 0; m < 4; ++m)
#pragma unroll
                for (int bj = 0; bj < 2; ++bj) wg[m][bj] = *(const u32x4*)(MG + (size_t)(row0 + ai * HALF + m * 16) * 3072 + 2048 + col0 + bj * HALF);
            __builtin_amdgcn_sched_barrier(0);
#pragma unroll
            for (int m = 0; m < 4; ++m) {
                const size_t row = (size_t)(row0 + ai * HALF + m * 16);
#pragma unroll
                for (int bj = 0; bj < 2; ++bj) {
                    f32x4 g0, g1; cvt8(wg[m][bj], g0, g1);
                    const f32x4 v0 = acc[ai][bj][m][0] * g0, v1 = acc[ai][bj][m][1] * g1;
                    u32x4 w; w.x = cvt_pk_bf16(v0[0], v0[1]); w.y = cvt_pk_bf16(v0[2], v0[3]); w.z = cvt_pk_bf16(v1[0], v1[1]); w.w = cvt_pk_bf16(v1[2], v1[3]);
                    *(u32x4*)(XN + row * 1024 + col0 + bj * HALF) = w;
                }
            }
        }
    }
};

template <bool BASE_BF16, bool OUT_BF16> struct EpiRes {
    static constexpr bool PERM = true, AFTER_DRAIN = false, HOOK = false;
    const void* base; void* out;
    __device__ __forceinline__ void operator()(const f32x4 (&acc)[2][2][4][2], const Unit& u, int wr, int wc, int fr, int fq) const {
        const int row0 = u.pm * BM + wr * 64 + fr, col0 = u.pn * BM + wc * 32 + 8 * fq;
#pragma unroll
        for (int ai = 0; ai < 2; ++ai) {
            f32x4 b0[4][2], b1[4][2];
#pragma unroll
            for (int m = 0; m < 4; ++m) {
                const size_t off = (size_t)(row0 + ai * HALF + m * 16) * 1024 + col0;
#pragma unroll
                for (int bj = 0; bj < 2; ++bj) {
                    if (BASE_BF16) { const u32x4 w = *(const u32x4*)((const bf16_t*)base + off + bj * HALF);
                        b0[m][bj][0] = __uint_as_float(w.x << 16); b0[m][bj][1] = __uint_as_float(w.x & 0xffff0000u); b0[m][bj][2] = __uint_as_float(w.y << 16); b0[m][bj][3] = __uint_as_float(w.y & 0xffff0000u);
                        b1[m][bj][0] = __uint_as_float(w.z << 16); b1[m][bj][1] = __uint_as_float(w.z & 0xffff0000u); b1[m][bj][2] = __uint_as_float(w.w << 16); b1[m][bj][3] = __uint_as_float(w.w & 0xffff0000u); }
                    else { b0[m][bj] = *(const f32x4*)((const float*)base + off + bj * HALF); b1[m][bj] = *(const f32x4*)((const float*)base + off + bj * HALF + 4); }
                }
            }
            __builtin_amdgcn_sched_barrier(0);
#pragma unroll
            for (int m = 0; m < 4; ++m) {
                const size_t off = (size_t)(row0 + ai * HALF + m * 16) * 1024 + col0;
#pragma unroll
                for (int bj = 0; bj < 2; ++bj) {
                    const f32x4 v0 = b0[m][bj] + acc[ai][bj][m][0], v1 = b1[m][bj] + acc[ai][bj][m][1];
                    if (OUT_BF16) { u32x4 w; w.x = cvt_pk_bf16(v0[0], v0[1]); w.y = cvt_pk_bf16(v0[2], v0[3]); w.z = cvt_pk_bf16(v1[0], v1[1]); w.w = cvt_pk_bf16(v1[2], v1[3]); *(u32x4*)((bf16_t*)out + off + bj * HALF) = w; }
                    else { *(f32x4*)((float*)out + off + bj * HALF) = v0; *(f32x4*)((float*)out + off + bj * HALF + 4) = v1; }
                }
            }
        }
    }
};

struct EpiStore {
    static constexpr bool PERM = true, AFTER_DRAIN = false, HOOK = false;
    bf16_t* O; int ldc;
    __device__ __forceinline__ void operator()(const f32x4 (&acc)[2][2][4][2], const Unit& u, int wr, int wc, int fr, int fq) const {
        const int row0 = u.pm * BM + wr * 64 + fr, col0 = u.pn * BM + wc * 32 + 8 * fq;
#pragma unroll
        for (int ai = 0; ai < 2; ++ai)
#pragma unroll
            for (int m = 0; m < 4; ++m) {
                bf16_t* rowp = O + (size_t)(row0 + ai * HALF + m * 16) * ldc + col0;
#pragma unroll
                for (int bj = 0; bj < 2; ++bj) { const f32x4 v0 = acc[ai][bj][m][0], v1 = acc[ai][bj][m][1];
                    u32x4 w; w.x = cvt_pk_bf16(v0[0], v0[1]); w.y = cvt_pk_bf16(v0[2], v0[3]); w.z = cvt_pk_bf16(v1[0], v1[1]); w.w = cvt_pk_bf16(v1[2], v1[3]); *(u32x4*)(rowp + bj * HALF) = w; }
            }
    }
};

template <class Epi, class Sched, bool ALIGN_EPI = false, bool SP2 = false>
__device__ __forceinline__ void gemm_phase(PG8_LAS unsigned char* lds, const Gemm g, const Sched& S, const Epi& E) {
    int tid_l = threadIdx.x; asm volatile("" : "+v"(tid_l));
    const int tid = tid_l, wid = __builtin_amdgcn_readfirstlane(tid >> 6), lane = tid & 63, wr = wid >> 2, wc = wid & 3, fr = lane & 15, fq = lane >> 4;
    const int K = g.K, nt = K / BK;
    unsigned voffA[2], voffB[2];
#pragma unroll
    for (int i = 0; i < 2; ++i) { int R, C; stage_rc(tid * 16 + i * 8192, R, C); const int Rb = Epi::PERM ? ((R & ~31) + perm32(R & 31)) : R;
        voffA[i] = (unsigned)(R * K + C) * 2u; voffB[i] = (unsigned)(Rb * K + C) * 2u; }
    const size_t kstep = (size_t)(BK * 2);
    const size_t hstep = (size_t)HALF * K * 2;
    const size_t tstep = 2 * hstep;
    const unsigned ldsw = (unsigned)wid * 1024u;
    const int aoff = lds_byte(wr * 64 + fr, fq * 8), boff = lds_byte(wc * 32 + fr, fq * 8);
#define PG8_SA(b, h) (((b) * 2 + (h)) * HTB)
#define PG8_SB(b, h) ((4 + (b) * 2 + (h)) * HTB)
#define PG8_STAGE(bufoff, gbase, voff) do { _Pragma("unroll") for (int _i = 0; _i < 2; ++_i) \
        __builtin_amdgcn_global_load_lds((const unsigned*)((const char*)(gbase) + (voff)[_i]), (PG8_LAS unsigned*)(lds + (bufoff) + ldsw + _i * 8192), 16, 0, 0); } while (0)
#define PG8_LDA(dst, b, h) do { _Pragma("unroll") for (int m = 0; m < 4; ++m) _Pragma("unroll") for (int k = 0; k < 2; ++k) dst[m][k] = *(const PG8_LAS bf16x8*)(lds + PG8_SA(b, h) + aoff + m * 2048 + k * 1024); } while (0)
#define PG8_LDB(dst, b, h) do { _Pragma("unroll") for (int n = 0; n < 2; ++n) _Pragma("unroll") for (int k = 0; k < 2; ++k) dst[n][k] = *(const PG8_LAS bf16x8*)(lds + PG8_SB(b, h) + boff + n * 2048 + k * 1024); } while (0)
#define PG8_MMA(ai, bj, At, Bt) do { __builtin_amdgcn_s_setprio(1); _Pragma("unroll") for (int m = 0; m < 4; ++m) _Pragma("unroll") for (int n = 0; n < 2; ++n) _Pragma("unroll") for (int k = 0; k < 2; ++k) \
        acc[ai][bj][m][n] = __builtin_amdgcn_mfma_f32_16x16x32_bf16(Bt[n][k], At[m][k], acc[ai][bj][m][n], 0, 0, 0); __builtin_amdgcn_s_setprio(0); } while (0)
#define PG8_WAIT_V(n) asm volatile("s_waitcnt vmcnt(" #n ")" ::: "memory")
#define PG8_WAIT_L(n) asm volatile("s_waitcnt lgkmcnt(" #n ")" ::: "memory")
#define PG8_BAR __builtin_amdgcn_s_barrier()
#define PG8_SCHED __builtin_amdgcn_sched_barrier(0)
    Unit cur, nxt; int ui = 0;
    if (!S.next(0, cur)) return;
    f32x4 acc[2][2][4][2];
#pragma unroll
    for (int a = 0; a < 2; ++a)
#pragma unroll
        for (int b = 0; b < 2; ++b)
#pragma unroll
            for (int m = 0; m < 4; ++m)
#pragma unroll
                for (int n = 0; n < 2; ++n) acc[a][b][m][n] = (f32x4){0.f, 0.f, 0.f, 0.f};
    bf16x8 At[4][2], B0[2][2], B1[2][2];
    const char* cA = (const char*)g.A + (size_t)cur.pm * tstep; const char* cB = (const char*)g.Bt + (size_t)cur.pn * tstep;
    S.a_ready(cur);
    if constexpr (SP2) {
        PG8_STAGE(PG8_SB(0, 0), cB, voffB); PG8_STAGE(PG8_SB(0, 1), cB + hstep, voffB); PG8_STAGE(PG8_SA(0, 0), cA, voffA); PG8_STAGE(PG8_SA(0, 1), cA + hstep, voffA);
        if (wr == 1) PG8_BAR;
        PG8_WAIT_V(2); PG8_BAR;
        PG8_STAGE(PG8_SB(1, 0), cB + kstep, voffB); PG8_STAGE(PG8_SA(1, 0), cA + kstep, voffA); PG8_STAGE(PG8_SB(1, 1), cB + hstep + kstep, voffB);
        PG8_WAIT_V(6); PG8_BAR;
    } else {
        PG8_STAGE(PG8_SB(0, 0), cB, voffB); PG8_STAGE(PG8_SA(0, 0), cA, voffA); PG8_STAGE(PG8_SB(0, 1), cB + hstep, voffB); PG8_STAGE(PG8_SA(0, 1), cA + hstep, voffA);
        if (wr == 1) PG8_BAR;
        PG8_WAIT_V(4); PG8_BAR;
        PG8_STAGE(PG8_SB(1, 0), cB + kstep, voffB); PG8_STAGE(PG8_SA(1, 0), cA + kstep, voffA); PG8_STAGE(PG8_SB(1, 1), cB + hstep + kstep, voffB);
        PG8_WAIT_V(6); PG8_BAR;
    }
    for (;;) {
        const bool has_next = S.next(ui + 1, nxt);
        const char* nA = has_next ? (const char*)g.A + (size_t)nxt.pm * tstep : cA; const char* nB = has_next ? (const char*)g.Bt + (size_t)nxt.pn * tstep : cB;
        const int nseg = Epi::HOOK ? 3 : 1, segt = nt / nseg;
        for (int seg = 0; seg < nseg; ++seg) {
        if constexpr (Epi::HOOK) { if (seg > 0) { __builtin_amdgcn_sched_barrier(0); E.hook(acc, cur, seg, wr, wc, fr, fq); __builtin_amdgcn_sched_barrier(0); } }
        for (int t = seg * segt; t < (seg + 1) * segt; t += 2) {
            const bool last = (t == nt - 2);
            const char* a1 = cA + (size_t)(t + 1) * kstep;
            const char* a2 = last ? nA : cA + (size_t)(t + 2) * kstep; const char* b2 = last ? nB : cB + (size_t)(t + 2) * kstep;
            const char* a3 = a2 + kstep; const char* b3 = b2 + kstep;
            if (last && has_next) S.a_ready(nxt);
            if constexpr (SP2) {
            PG8_LDB(B0, 0, 0); PG8_LDB(B1, 0, 1); PG8_SCHED; PG8_LDA(At, 0, 0); PG8_STAGE(PG8_SA(1, 1), a1 + hstep, voffA);
            PG8_WAIT_V(8); PG8_WAIT_L(0); PG8_BAR; PG8_MMA(0, 0, At, B0); PG8_MMA(0, 1, At, B1); PG8_BAR; PG8_SCHED;
            PG8_LDA(At, 0, 1); PG8_STAGE(PG8_SB(0, 0), b2, voffB); PG8_STAGE(PG8_SB(0, 1), b2 + hstep, voffB); PG8_STAGE(PG8_SA(0, 0), a2, voffA);
            PG8_WAIT_V(8); PG8_WAIT_L(0); PG8_BAR; PG8_MMA(1, 0, At, B0); PG8_MMA(1, 1, At, B1); PG8_BAR; PG8_SCHED;
            PG8_LDB(B0, 1, 0); PG8_LDB(B1, 1, 1); PG8_SCHED; PG8_LDA(At, 1, 0); PG8_STAGE(PG8_SA(0, 1), a2 + hstep, voffA);
            PG8_WAIT_V(8); PG8_WAIT_L(0); PG8_BAR; PG8_MMA(0, 0, At, B0); PG8_MMA(0, 1, At, B1); PG8_BAR; PG8_SCHED;
            PG8_LDA(At, 1, 1); PG8_STAGE(PG8_SB(1, 0), b3, voffB); PG8_STAGE(PG8_SB(1, 1), b3 + hstep, voffB); PG8_STAGE(PG8_SA(1, 0), a3, voffA);
            PG8_WAIT_V(8); PG8_WAIT_L(0); PG8_BAR; PG8_MMA(1, 0, At, B0); PG8_MMA(1, 1, At, B1); PG8_BAR; PG8_SCHED;
            } else {
            PG8_LDB(B0, 0, 0); PG8_SCHED; PG8_LDA(At, 0, 0); PG8_STAGE(PG8_SA(1, 1), a1 + hstep, voffA);
            PG8_WAIT_L(8); PG8_BAR; PG8_WAIT_L(0); PG8_MMA(0, 0, At, B0); PG8_BAR; PG8_SCHED;
            PG8_LDB(B1, 0, 1); PG8_STAGE(PG8_SB(0, 0), b2, voffB);
            PG8_BAR; PG8_WAIT_L(0); PG8_MMA(0, 1, At, B1); PG8_BAR;
            PG8_LDA(At, 0, 1); PG8_STAGE(PG8_SA(0, 0), a2, voffA);
            PG8_BAR; PG8_WAIT_L(0); PG8_MMA(1, 0, At, B0); PG8_BAR; PG8_SCHED;
            PG8_STAGE(PG8_SB(0, 1), b2 + hstep, voffB);
            PG8_WAIT_V(6); PG8_BAR; PG8_MMA(1, 1, At, B1); PG8_BAR;
            PG8_LDB(B0, 1, 0); PG8_SCHED; PG8_LDA(At, 1, 0); PG8_STAGE(PG8_SA(0, 1), a2 + hstep, voffA);
            PG8_WAIT_L(8); PG8_BAR; PG8_WAIT_L(0); PG8_MMA(0, 0, At, B0); PG8_BAR; PG8_SCHED;
            PG8_LDB(B1, 1, 1); PG8_STAGE(PG8_SB(1, 0), b3, voffB);
            PG8_BAR; PG8_WAIT_L(0); PG8_MMA(0, 1, At, B1); PG8_BAR;
            PG8_LDA(At, 1, 1); PG8_STAGE(PG8_SA(1, 0), a3, voffA);
            PG8_BAR; PG8_WAIT_L(0); PG8_MMA(1, 0, At, B0); PG8_BAR; PG8_SCHED;
            PG8_STAGE(PG8_SB(1, 1), b3 + hstep, voffB);
            PG8_WAIT_V(6); PG8_BAR; PG8_MMA(1, 1, At, B1); PG8_BAR;
            }
        }
        }
        if constexpr (ALIGN_EPI) { if (wr == 0) PG8_BAR; }
        if constexpr (!Epi::AFTER_DRAIN) { E(acc, cur, wr, wc, fr, fq); S.done(cur); }
        if (!has_next) break;
#pragma unroll
        for (int a = 0; a < 2; ++a)
#pragma unroll
            for (int b = 0; b < 2; ++b)
#pragma unroll
                for (int m = 0; m < 4; ++m)
#pragma unroll
                    for (int n = 0; n < 2; ++n) acc[a][b][m][n] = (f32x4){0.f, 0.f, 0.f, 0.f};
        cur = nxt; cA = nA; cB = nB; ++ui;
        if constexpr (ALIGN_EPI) { if (wr == 1) PG8_BAR; }
    }
    PG8_WAIT_V(0);
    if constexpr (!ALIGN_EPI) { if (wr == 0) PG8_BAR; }
    PG8_BAR;
    if constexpr (Epi::AFTER_DRAIN) { E.fused(acc, cur, wr, wc, fr, fq, lds, wid, lane); S.done(cur); }
#undef PG8_SA
#undef PG8_SB
#undef PG8_STAGE
#undef PG8_LDA
#undef PG8_LDB
#undef PG8_MMA
#undef PG8_WAIT_V
#undef PG8_WAIT_L
#undef PG8_BAR
#undef PG8_SCHED
}
}

namespace mk {
using pg8::bf16_t; using pg8::bf16x8; using pg8::f32x4; using pg8::cvt_pk_bf16;
#define LAS __attribute__((address_space(3)))
typedef float f32x16 __attribute__((ext_vector_type(16)));
typedef short v4i16 __attribute__((ext_vector_type(4)));
typedef unsigned u32x2 __attribute__((ext_vector_type(2)));
typedef unsigned u32x4 __attribute__((ext_vector_type(4)));

constexpr int BATCH = 32, SEQ = 2048, DM = 1024, NCHUNK = 2, BC = BATCH / NCHUNK, TC = BC * SEQ;
constexpr int PHW = 4352, NINP = 7680, DFF = 2816, NUP = 5632;
constexpr float LOG2E = 1.4426950408889634f;
constexpr size_t MiB = 1u << 20;
constexpr size_t WS_CTL = 0, CTL_BYTES = 32768, CTL_BAR = 4096;
constexpr size_t WS_W = 1 * MiB, LW = 40 * MiB;
constexpr size_t W_IN = 0, W_BR = 15 * MiB, W_O = 18 * MiB, W_UP = 20 * MiB, W_DN = 31 * MiB, W_1T = 37 * MiB, W_2T = 38 * MiB, W_B1 = 38 * MiB + 65536;
constexpr size_t WS_XN = 82 * MiB, WS_KC = 146 * MiB, WS_VC = 147 * MiB, WS_F = 148 * MiB, WS_HB = 150 * MiB  , WS_R = 214 * MiB;
constexpr size_t R_PH = 0, R_MG = 272 * MiB, R_GT = 464 * MiB, R_OA = 468 * MiB, R_OB = 500 * MiB, R_OC = 532 * MiB, R_MP = 0, R_UG = 0, R_ACT = 352 * MiB;
constexpr size_t WS_END = WS_R + 564 * MiB;
constexpr int L_KT = 0, L_VT = 18432, L_B1 = 36864  , L_MISC = 73728  , L_OX = 0  , L_SEL = 110592, L_UNI = L_SEL + 256, L_UQ = L_SEL + 512, L_FT = L_SEL + 1024  ;
constexpr int LDS_BYTES = 131072 + 1024;
constexpr int IMPS = 33;

struct Params { const float* in[22]; float* out; unsigned char* ws; int ph_lo, ph_hi; };

__device__ __forceinline__ float bf2f(unsigned short v) { return __uint_as_float(((unsigned)v) << 16); }
__device__ __forceinline__ float sigm(float x) { return __builtin_amdgcn_rcpf(1.0f + __builtin_amdgcn_exp2f(-1.4426950408889634f * x)); }
__device__ __forceinline__ float gelu_tanh(float x) { const float u = 0.7978845608028654f * (x + 0.044715f * x * x * x); return x * __builtin_amdgcn_rcpf(1.0f + __builtin_amdgcn_exp2f(-2.8853900817779268f * u)); }
__device__ __forceinline__ float ex2(float x) { return __builtin_amdgcn_exp2f(x); }
__device__ __forceinline__ f32x16 mfma32(bf16x8 a, bf16x8 b, f32x16 c) { return __builtin_amdgcn_mfma_f32_32x32x16_bf16(a, b, c, 0, 0, 0); }
__device__ __forceinline__ f32x4 mfma16(bf16x8 a, bf16x8 b, f32x4 c) { return __builtin_amdgcn_mfma_f32_16x16x32_bf16(a, b, c, 0, 0, 0); }
__device__ __forceinline__ bf16x8 vtr2(const LAS unsigned char* p, int step) {
    const v4i16 a = __builtin_amdgcn_ds_read_tr16_b64_v4i16((LAS v4i16*)p);
    const v4i16 b = __builtin_amdgcn_ds_read_tr16_b64_v4i16((LAS v4i16*)(p + step));
    return __builtin_shufflevector(a, b, 0, 1, 2, 3, 4, 5, 6, 7);
}
__device__ __forceinline__ bf16x8 pack8(float a0, float a1, float a2, float a3, float a4, float a5, float a6, float a7) {
    u32x4 w; w.x = cvt_pk_bf16(a0, a1); w.y = cvt_pk_bf16(a2, a3); w.z = cvt_pk_bf16(a4, a5); w.w = cvt_pk_bf16(a6, a7);
    return __builtin_bit_cast(bf16x8, w);
}
__device__ __forceinline__ float wave_sum(float v) {
#pragma unroll
    for (int o = 1; o < 64; o <<= 1) v += __shfl_xor(v, o);
    return v;
}

__device__ __forceinline__ int orig_in_col(int c) {
    if (c < 4352) { const int pn = c >> 8, l = c & 255, bj = l >> 7, wc = (l >> 5) & 3, j = l & 31; const int head = 4 * pn + wc, e = 32 * bj + j; return (head < 20 ? head * 64 : head * 64 + 24) + e; }
    if (c < 7424) return 4384 + (c - 4352);
    const int x = c - 7424; if (x < 24) return 1280 + x; if (x < 32) return 4376 + (x - 24); return -1;
}
template <int MODE>
__device__ __forceinline__ void transpose_mat(const float* src, int K, int Nsrc, bf16_t* dst, int Ndst, LAS float* tile, int tid, int ldd = 0) {
    if (ldd == 0) ldd = K;
    const int ntk = K / 64, nt = (Ndst / 64) * ntk;
    const int cc = tid & 63, kr = tid >> 6, c2 = tid >> 3, kc = (tid & 7) * 8;
    float nx[8];
    { const int it = blockIdx.x; if (it < nt) { const int tn = it / ntk, tk = it - tn * ntk; const int sc = MODE ? orig_in_col(tn * 64 + cc) : (tn * 64 + cc);
#pragma unroll
        for (int r = 0; r < 8; ++r) nx[r] = sc >= 0 ? src[(size_t)(tk * 64 + r * 8 + kr) * Nsrc + sc] : 0.f; } }
    for (int it = blockIdx.x; it < nt; it += gridDim.x) {
        const int tn = it / ntk, tk = it - tn * ntk, c0 = tn * 64, k0 = tk * 64;
        float cur[8];
#pragma unroll
        for (int r = 0; r < 8; ++r) cur[r] = nx[r];
        { const int it2 = it + gridDim.x; if (it2 < nt) { const int tn2 = it2 / ntk, tk2 = it2 - tn2 * ntk; const int sc2 = MODE ? orig_in_col(tn2 * 64 + cc) : (tn2 * 64 + cc);
#pragma unroll
            for (int r = 0; r < 8; ++r) nx[r] = sc2 >= 0 ? src[(size_t)(tk2 * 64 + r * 8 + kr) * Nsrc + sc2] : 0.f; } }
#pragma unroll
        for (int r = 0; r < 8; ++r) tile[(r * 8 + kr) * 65 + cc] = cur[r];
        asm volatile("s_waitcnt lgkmcnt(0)" ::: "memory"); __builtin_amdgcn_s_barrier(); asm volatile("" ::: "memory");
        float v[8];
#pragma unroll
        for (int i = 0; i < 8; ++i) v[i] = tile[(kc + i) * 65 + c2];
        u32x4 w; w.x = cvt_pk_bf16(v[0], v[1]); w.y = cvt_pk_bf16(v[2], v[3]); w.z = cvt_pk_bf16(v[4], v[5]); w.w = cvt_pk_bf16(v[6], v[7]);
        *(u32x4*)(dst + (size_t)(c0 + c2) * ldd + k0 + kc) = w;
        asm volatile("s_waitcnt lgkmcnt(0)" ::: "memory"); __builtin_amdgcn_s_barrier(); asm volatile("" ::: "memory");
    }
}
__device__ __forceinline__ void p0_prologue(const Params& p, LAS unsigned char* lds, int tid) {
    LAS float* tile = (LAS float*)lds;
    if (blockIdx.x < 4) {
        const int l = blockIdx.x >> 1, kv = blockIdx.x & 1, n = tid & 127, part = tid >> 7;
        const float* pe = p.in[5] + (size_t)(l * 2 + kv) * 2048; const float* w1 = p.in[6] + (size_t)(l * 2 + kv) * 2048 * 128;
        float s = 0.f;
        for (int k = part * 512; k < part * 512 + 512; ++k) s += pe[k] * w1[(size_t)k * 128 + n];
        tile[part * 128 + n] = s;
        __syncthreads();
        if (tid < 128) { float* b1 = (float*)(p.ws + WS_W + l * LW + W_B1); b1[kv * 128 + tid] = (tile[tid] + tile[128 + tid]) + (tile[256 + tid] + tile[384 + tid]); }
        __syncthreads();
    }
    for (int l = 0; l < 2; ++l) {
        unsigned char* wb = p.ws + WS_W + l * LW;
        transpose_mat<1>(p.in[2] + (size_t)l * 1024 * 7456, 1024, 7456, (bf16_t*)(wb + W_IN), NINP, tile, tid);
        for (int i = 0; i < 3; ++i) transpose_mat<0>(p.in[15] + (size_t)(l * 3 + i) * 512 * 1024, 512, 1024, (bf16_t*)(wb + W_BR) + (size_t)i * 512, 1024, tile, tid, 1536);
        transpose_mat<0>(p.in[16] + (size_t)l * 1024 * 1024, 1024, 1024, (bf16_t*)(wb + W_O), 1024, tile, tid);
        transpose_mat<0>(p.in[18] + (size_t)l * 1024 * NUP, 1024, NUP, (bf16_t*)(wb + W_UP), NUP, tile, tid);
        transpose_mat<0>(p.in[21] + (size_t)l * DFF * 1024, DFF, 1024, (bf16_t*)(wb + W_DN), 1024, tile, tid);
        for (int kv = 0; kv < 2; ++kv) {
            transpose_mat<0>(p.in[6] + (size_t)(l * 2 + kv) * 2048 * 128, 2048, 128, (bf16_t*)(wb + W_1T) + (size_t)kv * 128 * 2048, 128, tile, tid);
            transpose_mat<0>(p.in[7] + (size_t)(l * 2 + kv) * 128 * 64, 128, 64, (bf16_t*)(wb + W_2T) + (size_t)kv * 64 * 128, 64, tile, tid);
        }
    }
}

template <bool SRC_BF16>
__device__ __forceinline__ void norm_phase(const void* srcv, const float* g, bf16_t* XN, int wid, int lane) {
    f32x4 gv[4];
#pragma unroll
    for (int i = 0; i < 4; ++i) gv[i] = *(const f32x4*)(g + 4 * (lane + 64 * i));
    for (int row0 = (blockIdx.x * 8 + wid) * 4; row0 < TC; row0 += gridDim.x * 8 * 4) {
        f32x4 v[4][4]; float ss[4];
#pragma unroll
        for (int r = 0; r < 4; ++r)
#pragma unroll
            for (int i = 0; i < 4; ++i) {
                if (SRC_BF16) { const u32x2 w = *(const u32x2*)((const bf16_t*)srcv + (size_t)(row0 + r) * 1024 + 4 * (lane + 64 * i));
                    v[r][i][0] = __uint_as_float(w.x << 16); v[r][i][1] = __uint_as_float(w.x & 0xffff0000u); v[r][i][2] = __uint_as_float(w.y << 16); v[r][i][3] = __uint_as_float(w.y & 0xffff0000u); }
                else v[r][i] = *(const f32x4*)((const float*)srcv + (size_t)(row0 + r) * 1024 + 4 * (lane + 64 * i)); }
#pragma unroll
        for (int r = 0; r < 4; ++r) { float s = 0.f;
#pragma unroll
            for (int i = 0; i < 4; ++i) s += (v[r][i][0] * v[r][i][0] + v[r][i][1] * v[r][i][1]) + (v[r][i][2] * v[r][i][2] + v[r][i][3] * v[r][i][3]);
            ss[r] = wave_sum(s); }
#pragma unroll
        for (int r = 0; r < 4; ++r) { const float rr = rsqrtf(ss[r] * (1.0f / 1024.0f) + 1e-6f);
#pragma unroll
            for (int i = 0; i < 4; ++i) { const f32x4 o = v[r][i] * rr * gv[i]; u32x2 w; w.x = cvt_pk_bf16(o[0], o[1]); w.y = cvt_pk_bf16(o[2], o[3]); *(u32x2*)(XN + (size_t)(row0 + r) * 1024 + 4 * (lane + 64 * i)) = w; } }
    }
}

__device__ __forceinline__ void prep_phase(const Params& p, LAS unsigned char* lds, int layer, int wid, int lane) {
    unsigned char* ws = p.ws; unsigned char* wb = ws + WS_W + layer * LW;
    const bf16_t* PH = (const bf16_t*)(ws + WS_R + R_PH);
    const float* GT = (const float*)(ws + WS_R + R_GT);
    const int l16 = lane & 15, G = lane >> 4, grp = wid >> 2, wq = wid & 3;
    for (int wu0 = blockIdx.x * 2; wu0 < 512; wu0 += gridDim.x * 2) {
        const int wu = wu0 + grp;
        const int nt = wu & 7, kv = (wu >> 3) & 1, g = (wu >> 4) & 1, b = wu >> 5;
        const int n = nt * 16 + l16; const int nn = n < 127 ? n : 126;
        const bf16_t* w1t = (const bf16_t*)(wb + W_1T) + (size_t)kv * 128 * 2048;
        const bf16_t* w2t = (const bf16_t*)(wb + W_2T) + (size_t)kv * 64 * 128;
        const float* b1 = (const float*)(wb + W_B1) + kv * 128;
        const bf16_t* src = PH + (size_t)(b * SEQ + 16 * nn) * PHW + (8 + kv * 2 + g) * 64 + 8 * G;
        const bf16_t* wa = w1t + (size_t)l16 * 2048 + 8 * G;
        f32x4 acc[8];
#pragma unroll
        for (int mt = 0; mt < 8; ++mt) acc[mt] = (f32x4){0.f, 0.f, 0.f, 0.f};
        for (int ks0 = wq * 16; ks0 < wq * 16 + 16; ks0 += 4) {
            bf16x8 bfr[4], afr[4][8];
#pragma unroll
            for (int q = 0; q < 4; ++q) { const int ks = ks0 + q; bfr[q] = *(const bf16x8*)(src + (size_t)(ks >> 1) * PHW + (ks & 1) * 32);
#pragma unroll
                for (int mt = 0; mt < 8; ++mt) afr[q][mt] = *(const bf16x8*)(wa + (size_t)mt * 16 * 2048 + ks * 32); }
#pragma unroll
            for (int q = 0; q < 4; ++q)
#pragma unroll
                for (int mt = 0; mt < 8; ++mt) acc[mt] = mfma16(afr[q][mt], bfr[q], acc[mt]);
        }
        LAS f32x4* red = (LAS f32x4*)(lds + (grp * 3) * 8192);
        if (wq > 0) {
#pragma unroll
            for (int mt = 0; mt < 8; ++mt) red[(wq - 1) * 512 + mt * 64 + lane] = acc[mt];
        }
        __syncthreads();
        if (wq == 0) {
#pragma unroll
            for (int mt = 0; mt < 8; ++mt) acc[mt] = ((acc[mt] + red[mt * 64 + lane]) + red[512 + mt * 64 + lane]) + red[1024 + mt * 64 + lane];
#pragma unroll
            for (int mt = 0; mt < 8; ++mt) { const f32x4 bb = *(const f32x4*)(b1 + 16 * mt + 4 * G);
#pragma unroll
                for (int j = 0; j < 4; ++j) acc[mt][j] = gelu_tanh(acc[mt][j] + bb[j]); }
            f32x4 oc[4];
#pragma unroll
            for (int dt = 0; dt < 4; ++dt) oc[dt] = (f32x4){0.f, 0.f, 0.f, 0.f};
#pragma unroll
            for (int s = 0; s < 4; ++s) {
                const bf16x8 bfr = pack8(acc[2 * s][0], acc[2 * s][1], acc[2 * s][2], acc[2 * s][3], acc[2 * s + 1][0], acc[2 * s + 1][1], acc[2 * s + 1][2], acc[2 * s + 1][3]);
#pragma unroll
                for (int dt = 0; dt < 4; ++dt) {
                    const bf16_t* ap = w2t + (size_t)(16 * dt + l16) * 128 + 32 * s + 4 * G;
                    const u32x2 lo = *(const u32x2*)ap, hi = *(const u32x2*)(ap + 16);
                    u32x4 w; w.x = lo.x; w.y = lo.y; w.z = hi.x; w.w = hi.y;
                    oc[dt] = mfma16(__builtin_bit_cast(bf16x8, w), bfr, oc[dt]);
                }
            }
            if (kv == 0) {
                float ss = 0.f;
#pragma unroll
                for (int dt = 0; dt < 4; ++dt) ss += (oc[dt][0] * oc[dt][0] + oc[dt][1] * oc[dt][1]) + (oc[dt][2] * oc[dt][2] + oc[dt][3] * oc[dt][3]);
                ss += __shfl_xor(ss, 16); ss += __shfl_xor(ss, 32);
                const float r = rsqrtf(ss * (1.0f / 64.0f) + 1e-6f);
                const float* kg = p.in[4] + (size_t)layer * 192;
#pragma unroll
                for (int dt = 0; dt < 4; ++dt) { const f32x4 gg = *(const f32x4*)(kg + 16 * dt + 4 * G); oc[dt] = oc[dt] * r * gg; }
            }
            bf16_t* dst = (bf16_t*)(ws + (kv ? WS_VC : WS_KC)) + ((size_t)(b * 2 + g) * 128 + n) * 64 + 4 * G;
            const bool live = n < 127;
#pragma unroll
            for (int dt = 0; dt < 4; ++dt) { u32x2 w; w.x = live ? cvt_pk_bf16(oc[dt][0], oc[dt][1]) : 0u; w.y = live ? cvt_pk_bf16(oc[dt][2], oc[dt][3]) : 0u; *(u32x2*)(dst + 16 * dt) = w; }
        } else if (wq == 1 && wu < 128) {
            const int bh = wu, bb_ = bh >> 3, h = bh & 7;
            const float fb = p.in[14][layer * 8 + h];
            const float* gp = GT + (size_t)(bb_ * SEQ + 32 * lane) * 32 + 24 + h;
            float v[32]; float run = 0.f;
#pragma unroll
            for (int i = 0; i < 32; ++i) { const float x = gp[(size_t)i * 32] + fb; const float lsg = fminf(x, 0.f) - log1pf(__expf(-fabsf(x))); run += lsg; v[i] = run; }
            float incl = run;
#pragma unroll
            for (int o = 1; o < 64; o <<= 1) { const float t_ = __shfl_up(incl, o); if (lane >= o) incl += t_; }
            const float excl = incl - run;
            float* fo = (float*)(ws + WS_F) + (size_t)bh * SEQ + 32 * lane;
#pragma unroll
            for (int i = 0; i < 32; i += 4) *(f32x4*)(fo + i) = (f32x4){v[i] + excl, v[i + 1] + excl, v[i + 2] + excl, v[i + 3] + excl} * (-LOG2E);
        }
        __syncthreads();
    }
}

typedef float f32x2_t __attribute__((ext_vector_type(2))); typedef __bf16 bf16x2_t __attribute__((ext_vector_type(2)));
__device__ __forceinline__ unsigned cvtpk(float lo, float hi) { const f32x2_t v = {lo, hi}; const bf16x2_t r = __builtin_convertvector(v, bf16x2_t); return __builtin_bit_cast(unsigned, r); }
__device__ __forceinline__ bf16x8 pack8n(float a0, float a1, float a2, float a3, float a4, float a5, float a6, float a7) {
    u32x4 w; w.x = cvtpk(a0, a1); w.y = cvtpk(a2, a3); w.z = cvtpk(a4, a5); w.w = cvtpk(a6, a7);
    return __builtin_bit_cast(bf16x8, w);
}
constexpr float QKB = 16.0f;
template <bool FOX, int DV>
__device__ __forceinline__ void attn_tile64(bool MASKED, const LAS unsigned char* Kt, int krow, const LAS unsigned char* Vt, int vrow, const bf16x8 (&qf)[4], f32x16 (&o)[DV / 32], f32x16& lacc,
                                            int lane, int tpos, int kbase, float slope2, float rowc, bool rowsel, int win, const LAS float* Ft) {
    __builtin_amdgcn_sched_barrier(0);
    const int l32 = lane & 31, g = lane >> 5;
    f32x16 s[2];
    if (FOX) {
#pragma unroll
        for (int kb = 0; kb < 2; ++kb)
#pragma unroll
            for (int a = 0; a < 4; ++a) { const f32x4 f = *(const LAS f32x4*)(Ft + 32 * kb + 8 * a + 4 * g); s[kb][4 * a] = f[0] - rowc; s[kb][4 * a + 1] = f[1] - rowc; s[kb][4 * a + 2] = f[2] - rowc; s[kb][4 * a + 3] = f[3] - rowc; }
    } else {
        const float base = slope2 * (float)(kbase + 4 * g - tpos) - QKB;
#pragma unroll
        for (int kb = 0; kb < 2; ++kb)
#pragma unroll
            for (int j = 0; j < 16; ++j) s[kb][j] = fmaf(slope2, (float)(32 * kb + 8 * (j >> 2) + (j & 3)), base);
    }
#pragma unroll
    for (int kb = 0; kb < 2; ++kb)
#pragma unroll
        for (int ks = 0; ks < 4; ++ks) { const bf16x8 a = *(const LAS bf16x8*)(Kt + (32 * kb + l32) * krow + (16 * ks + 8 * g) * 2); s[kb] = mfma32(a, qf[ks], s[kb]); }
    if (MASKED) {
        const int rel = tpos - kbase - 4 * g;
#pragma unroll
        for (int kb = 0; kb < 2; ++kb)
#pragma unroll
            for (int j = 0; j < 16; ++j) { const int c = 32 * kb + 8 * (j >> 2) + (j & 3); const bool ok = rowsel && (c <= rel) && (rel - c < win); s[kb][j] = ok ? s[kb][j] : -1e30f; }
    }
#pragma unroll
    for (int kb = 0; kb < 2; ++kb)
#pragma unroll
        for (int j = 0; j < 16; ++j) s[kb][j] = ex2(s[kb][j]);
    bf16x8 pb[2][2];
#pragma unroll
    for (int kb = 0; kb < 2; ++kb)
#pragma unroll
        for (int kk = 0; kk < 2; ++kk) pb[kb][kk] = pack8n(s[kb][8 * kk], s[kb][8 * kk + 1], s[kb][8 * kk + 2], s[kb][8 * kk + 3], s[kb][8 * kk + 4], s[kb][8 * kk + 5], s[kb][8 * kk + 6], s[kb][8 * kk + 7]);
    const LAS unsigned char* vb = Vt + (4 * g + ((lane & 15) >> 2)) * vrow + (16 * ((lane >> 4) & 1) + 4 * (lane & 3)) * 2;
    const bf16x8 ones = (bf16x8){0x3F80, 0x3F80, 0x3F80, 0x3F80, 0x3F80, 0x3F80, 0x3F80, 0x3F80};
#pragma unroll
    for (int kb = 0; kb < 2; ++kb)
#pragma unroll
        for (int kk = 0; kk < 2; ++kk) lacc = mfma32(ones, pb[kb][kk], lacc);
#pragma unroll
    for (int dt = 0; dt < DV / 32; ++dt) {
#pragma unroll
        for (int kb = 0; kb < 2; ++kb)
#pragma unroll
            for (int kk = 0; kk < 2; ++kk) { const bf16x8 a = vtr2(vb + (32 * kb + 16 * kk) * vrow + 64 * dt, 8 * vrow); o[dt] = mfma32(a, pb[kb][kk], o[dt]); }
        }
    __builtin_amdgcn_sched_barrier(0);
}

__device__ __forceinline__ void zero16(f32x16& v) {
#pragma unroll
    for (int j = 0; j < 16; ++j) v[j] = 0.f;
}

__device__ __forceinline__ void fox_unit(const Params& p, LAS unsigned char* lds, int b, int h, int qb, int tid, int wid, int lane) {
    unsigned char* ws = p.ws;
    const bf16_t* PH = (const bf16_t*)(ws + WS_R + R_PH); bf16_t* OC = (bf16_t*)(ws + WS_R + R_OA) + 1024;
    const float* nF2 = (const float*)(ws + WS_F) + (size_t)(b * 8 + h) * SEQ;
    const int l32 = lane & 31, g = lane >> 5, tokbase = b * SEQ;
    const int q0 = 256 * qb + 32 * wid, tpos = q0 + l32;
    bf16x8 qf[4];
#pragma unroll
    for (int ks = 0; ks < 4; ++ks) qf[ks] = *(const bf16x8*)(PH + (size_t)(tokbase + tpos) * PHW + (44 + h) * 64 + 16 * ks + 8 * g);
    f32x16 o[2], lacc; zero16(o[0]); zero16(o[1]); zero16(lacc);
    const float rowc = nF2[tpos] + QKB;
    const int ntiles = 4 * qb + 4, srow = tid >> 3, sch = tid & 7;
    const bf16_t* kg = PH + (size_t)(tokbase + srow) * PHW + (52 + h) * 64 + sch * 8;
    const bf16_t* vg = PH + (size_t)(tokbase + srow) * PHW + (60 + h) * 64 + sch * 8;
    u32x4 kA, vA, kB, vB; f32x4 fA, fB;
    { const int n_ = ntiles;
      kA = *(const u32x4*)(kg + (size_t)(0) * 64 * PHW); vA = *(const u32x4*)(vg + (size_t)(0) * 64 * PHW); fA = *(const f32x4*)(nF2 + (0) * 64 + 4 * (tid & 15)); if (n_ > 1) { kB = *(const u32x4*)(kg + (size_t)(1) * 64 * PHW); vB = *(const u32x4*)(vg + (size_t)(1) * 64 * PHW); fB = *(const f32x4*)(nF2 + (1) * 64 + 4 * (tid & 15)); }
      *(LAS u32x4*)(lds + 0 + L_KT + srow * 144 + sch * 16) = kA; *(LAS u32x4*)(lds + 0 + L_VT + srow * 192 + sch * 16) = vA; if (tid < 16) *(LAS f32x4*)(lds + L_FT + 0 * 256 + tid * 16) = fA; if (n_ > 2) { kA = *(const u32x4*)(kg + (size_t)(2) * 64 * PHW); vA = *(const u32x4*)(vg + (size_t)(2) * 64 * PHW); fA = *(const f32x4*)(nF2 + (2) * 64 + 4 * (tid & 15)); }
      __syncthreads();
#pragma unroll 1
      for (int i_ = 0; i_ < n_; i_ += 2) {
        if (i_ + 1 < n_) { *(LAS u32x4*)(lds + L_B1 + L_KT + srow * 144 + sch * 16) = kB; *(LAS u32x4*)(lds + L_B1 + L_VT + srow * 192 + sch * 16) = vB; if (tid < 16) *(LAS f32x4*)(lds + L_FT + 1 * 256 + tid * 16) = fB; if (i_ + 3 < n_) { kB = *(const u32x4*)(kg + (size_t)((i_ + 3)) * 64 * PHW); vB = *(const u32x4*)(vg + (size_t)((i_ + 3)) * 64 * PHW); fB = *(const f32x4*)(nF2 + ((i_ + 3)) * 64 + 4 * (tid & 15)); } }
        if (64 * i_ <= q0 + 31) attn_tile64<true, 64>(64 * i_ + 63 > q0, lds + 0 + L_KT, 144, lds + 0 + L_VT, 192, qf, o, lacc, lane, tpos, 64 * i_, 0.f, rowc, true, 1 << 30, (const LAS float*)(lds + L_FT + 0 * 256));
        __syncthreads();
        if (i_ + 1 < n_) {
          if (i_ + 2 < n_) { *(LAS u32x4*)(lds + 0 + L_KT + srow * 144 + sch * 16) = kA; *(LAS u32x4*)(lds + 0 + L_VT + srow * 192 + sch * 16) = vA; if (tid < 16) *(LAS f32x4*)(lds + L_FT + 0 * 256 + tid * 16) = fA; if (i_ + 4 < n_) { kA = *(const u32x4*)(kg + (size_t)((i_ + 4)) * 64 * PHW); vA = *(const u32x4*)(vg + (size_t)((i_ + 4)) * 64 * PHW); fA = *(const f32x4*)(nF2 + ((i_ + 4)) * 64 + 4 * (tid & 15)); } }
          if (64 * (i_ + 1) <= q0 + 31) attn_tile64<true, 64>(64 * (i_ + 1) + 63 > q0, lds + L_B1 + L_KT, 144, lds + L_B1 + L_VT, 192, qf, o, lacc, lane, tpos, 64 * (i_ + 1), 0.f, rowc, true, 1 << 30, (const LAS float*)(lds + L_FT + 1 * 256));
          __syncthreads();
        }
      }
    }
    const float inv = 1.0f / lacc[0];
    bf16_t* op = OC + (size_t)(tokbase + tpos) * 1536 + h * 64 + 4 * g;
#pragma unroll
    for (int dt = 0; dt < 2; ++dt)
#pragma unroll
        for (int a = 0; a < 4; ++a) { u32x2 w; w.x = cvt_pk_bf16(o[dt][4 * a] * inv, o[dt][4 * a + 1] * inv); w.y = cvt_pk_bf16(o[dt][4 * a + 2] * inv, o[dt][4 * a + 3] * inv); *(u32x2*)(op + 32 * dt + 8 * a) = w; }
}

__device__ __forceinline__ void diff_unit(const Params& p, LAS unsigned char* lds, int layer, int b, int h, int qt, int tid, int wid, int lane) {
    unsigned char* ws = p.ws;
    const bf16_t* PH = (const bf16_t*)(ws + WS_R + R_PH); bf16_t* OB = (bf16_t*)(ws + WS_R + R_OA) + 512;
    const int l32 = lane & 31, g = lane >> 5, tokbase = b * SEQ, c = wid >> 2, wq = wid & 3;
    const int q0 = 128 * qt + 32 * wq, tpos = q0 + l32;
    const float* lv = p.in[10] + (size_t)layer * 256;
    const float lam_init = 0.8f - 0.6f * __expf(-0.3f * (float)layer);
    const float lam = __expf(wave_sum(lv[lane] * lv[64 + lane])) - __expf(wave_sum(lv[128 + lane] * lv[192 + lane])) + lam_init;
    bf16x8 qf[4];
#pragma unroll
    for (int ks = 0; ks < 4; ++ks) qf[ks] = *(const bf16x8*)(PH + (size_t)(tokbase + tpos) * PHW + (20 + 2 * h + c) * 64 + 16 * ks + 8 * g);
    const float slope2 = ex2(-2.0f * (float)(h + 1)) * LOG2E;
    f32x16 o[4], lacc; zero16(o[0]); zero16(o[1]); zero16(o[2]); zero16(o[3]); zero16(lacc);
    const int ntiles = 2 * qt + 2;
    const int r0 = tid >> 4, ch = tid & 15;
    const bf16_t* kg = PH + (size_t)(tokbase + r0) * PHW + (28 + 2 * h) * 64 + ch * 8;
    const bf16_t* vg = PH + (size_t)(tokbase + r0) * PHW + (36 + 2 * h) * 64 + ch * 8;
    u32x4 kA0, kA1, vA0, vA1, kB0, kB1, vB0, vB1;
    { const int n_ = ntiles;
      { const size_t off = (size_t)(0) * 64 * PHW; kA0 = *(const u32x4*)(kg + off); kA1 = *(const u32x4*)(kg + off + (size_t)32 * PHW); vA0 = *(const u32x4*)(vg + off); vA1 = *(const u32x4*)(vg + off + (size_t)32 * PHW); } if (n_ > 1) { { const size_t off = (size_t)(1) * 64 * PHW; kB0 = *(const u32x4*)(kg + off); kB1 = *(const u32x4*)(kg + off + (size_t)32 * PHW); vB0 = *(const u32x4*)(vg + off); vB1 = *(const u32x4*)(vg + off + (size_t)32 * PHW); } }
      *(LAS u32x4*)(lds + 0 + L_KT + r0 * 272 + ch * 16) = kA0; *(LAS u32x4*)(lds + 0 + L_KT + (r0 + 32) * 272 + ch * 16) = kA1; *(LAS u32x4*)(lds + 0 + 17408 + r0 * 320 + ch * 16) = vA0; *(LAS u32x4*)(lds + 0 + 17408 + (r0 + 32) * 320 + ch * 16) = vA1; if (n_ > 2) { { const size_t off = (size_t)(2) * 64 * PHW; kA0 = *(const u32x4*)(kg + off); kA1 = *(const u32x4*)(kg + off + (size_t)32 * PHW); vA0 = *(const u32x4*)(vg + off); vA1 = *(const u32x4*)(vg + off + (size_t)32 * PHW); } }
      __syncthreads();
#pragma unroll 1
      for (int i_ = 0; i_ < n_; i_ += 2) {
        if (i_ + 1 < n_) { *(LAS u32x4*)(lds + 40960 + L_KT + r0 * 272 + ch * 16) = kB0; *(LAS u32x4*)(lds + 40960 + L_KT + (r0 + 32) * 272 + ch * 16) = kB1; *(LAS u32x4*)(lds + 40960 + 17408 + r0 * 320 + ch * 16) = vB0; *(LAS u32x4*)(lds + 40960 + 17408 + (r0 + 32) * 320 + ch * 16) = vB1; if (i_ + 3 < n_) { { const size_t off = (size_t)((i_ + 3)) * 64 * PHW; kB0 = *(const u32x4*)(kg + off); kB1 = *(const u32x4*)(kg + off + (size_t)32 * PHW); vB0 = *(const u32x4*)(vg + off); vB1 = *(const u32x4*)(vg + off + (size_t)32 * PHW); } } }
        if (64 * i_ <= q0 + 31) attn_tile64<false, 128>(64 * i_ + 63 > q0, lds + 0 + L_KT + c * 128, 272, lds + 0 + 17408, 320, qf, o, lacc, lane, tpos, 64 * i_, slope2, 0.f, true, 1 << 30, nullptr);
        __syncthreads();
        if (i_ + 1 < n_) {
          if (i_ + 2 < n_) { *(LAS u32x4*)(lds + 0 + L_KT + r0 * 272 + ch * 16) = kA0; *(LAS u32x4*)(lds + 0 + L_KT + (r0 + 32) * 272 + ch * 16) = kA1; *(LAS u32x4*)(lds + 0 + 17408 + r0 * 320 + ch * 16) = vA0; *(LAS u32x4*)(lds + 0 + 17408 + (r0 + 32) * 320 + ch * 16) = vA1; if (i_ + 4 < n_) { { const size_t off = (size_t)((i_ + 4)) * 64 * PHW; kA0 = *(const u32x4*)(kg + off); kA1 = *(const u32x4*)(kg + off + (size_t)32 * PHW); vA0 = *(const u32x4*)(vg + off); vA1 = *(const u32x4*)(vg + off + (size_t)32 * PHW); } } }
          if (64 * (i_ + 1) <= q0 + 31) attn_tile64<false, 128>(64 * (i_ + 1) + 63 > q0, lds + 40960 + L_KT + c * 128, 272, lds + 40960 + 17408, 320, qf, o, lacc, lane, tpos, 64 * (i_ + 1), slope2, 0.f, true, 1 << 30, nullptr);
          __syncthreads();
        }
      }
    }
    const float inv = 1.0f / lacc[0];
    LAS float* OX = (LAS float*)(lds + L_OX);
    const int ql = 32 * wq + l32;
    if (c == 1) {
        const float f = inv * lam;
#pragma unroll
        for (int dt = 0; dt < 4; ++dt)
#pragma unroll
            for (int j = 0; j < 16; ++j) { const int d = 32 * dt + 8 * (j >> 2) + 4 * g + (j & 3); OX[d * 128 + ql] = o[dt][j] * f; }
    }
    __syncthreads();
    if (c == 0) {
        float ss = 0.f;
#pragma unroll
        for (int dt = 0; dt < 4; ++dt)
#pragma unroll
            for (int j = 0; j < 16; ++j) { const int d = 32 * dt + 8 * (j >> 2) + 4 * g + (j & 3); const float v = o[dt][j] * inv - OX[d * 128 + ql]; o[dt][j] = v; ss += v * v; }
        ss += __shfl_xor(ss, 32);
        const float r = rsqrtf(ss * (1.0f / 128.0f) + 1e-6f) * (1.0f - lam_init);
        const float* sg = p.in[11] + (size_t)layer * 128;
        bf16_t* op = OB + (size_t)(tokbase + tpos) * 1536 + h * 128 + 4 * g;
        f32x4 gg[4][4];
#pragma unroll
        for (int dt = 0; dt < 4; ++dt)
#pragma unroll
            for (int a = 0; a < 4; ++a) gg[dt][a] = *(const f32x4*)(sg + 32 * dt + 8 * a + 4 * g);
#pragma unroll
        for (int dt = 0; dt < 4; ++dt)
#pragma unroll
            for (int a = 0; a < 4; ++a) {
                u32x2 w; w.x = cvt_pk_bf16(o[dt][4 * a] * r * gg[dt][a][0], o[dt][4 * a + 1] * r * gg[dt][a][1]); w.y = cvt_pk_bf16(o[dt][4 * a + 2] * r * gg[dt][a][2], o[dt][4 * a + 3] * r * gg[dt][a][3]); *(u32x2*)(op + 32 * dt + 8 * a) = w; }
    }
}

__device__ __forceinline__ void nsa_unit(const Params& p, LAS unsigned char* lds, int b, int gq, int tq, int tid, int wid, int lane) {
    unsigned char* ws = p.ws;
    const bf16_t* PH = (const bf16_t*)(ws + WS_R + R_PH); bf16_t* OA = (bf16_t*)(ws + WS_R + R_OA);
    const float* GT = (const float*)(ws + WS_R + R_GT);
    const int l32 = lane & 31, g = lane >> 5, tokbase = b * SEQ, r = wid >> 1, th = wid & 1, head = gq * 4 + r;
    const int t0 = 64 * tq, tl = 32 * th + l32, tpos = t0 + tl;
    const float slope2 = ex2(-(float)(head + 1)) * LOG2E;
    bf16x8 qf[4];
#pragma unroll
    for (int ks = 0; ks < 4; ++ks) qf[ks] = *(const bf16x8*)(PH + (size_t)(tokbase + tpos) * PHW + head * 64 + 16 * ks + 8 * g);
    const float* gtp = GT + (size_t)(tokbase + tpos) * 32 + head;
    const float gc = sigm(gtp[0]), gs = sigm(gtp[8]), gw = sigm(gtp[16]);
    const int srow = tid >> 3, sch = tid & 7, j0 = tq >= 4 ? tq - 4 : 0;
    const u32x4 kS0 = *(const u32x4*)(PH + (size_t)(tokbase + srow) * PHW + (12 + gq) * 64 + sch * 8), vS0 = *(const u32x4*)(PH + (size_t)(tokbase + srow) * PHW + (14 + gq) * 64 + sch * 8);
    const u32x4 kW0 = *(const u32x4*)(PH + (size_t)(tokbase + j0 * 64 + srow) * PHW + (16 + gq) * 64 + sch * 8), vW0 = *(const u32x4*)(PH + (size_t)(tokbase + j0 * 64 + srow) * PHW + (18 + gq) * 64 + sch * 8);
    f32x16 tot[2];
    LAS float* IMP = (LAS float*)(lds + L_MISC);
    LAS unsigned* SEL = (LAS unsigned*)(lds + L_SEL);
    {
        const bf16_t* kc = (const bf16_t*)(ws + WS_KC) + (size_t)(b * 2 + gq) * 128 * 64;
        const bf16_t* vc = (const bf16_t*)(ws + WS_VC) + (size_t)(b * 2 + gq) * 128 * 64;
        __syncthreads();
#pragma unroll
        for (int i = 0; i < 2; ++i) { const int idx = tid + 512 * i, row = idx >> 3, ch = idx & 7;
            *(LAS u32x4*)(lds + L_KT + row * 144 + ch * 16) = *(const u32x4*)(kc + row * 64 + ch * 8);
            *(LAS u32x4*)(lds + L_VT + row * 192 + ch * 16) = *(const u32x4*)(vc + row * 64 + ch * 8); }
        __syncthreads();
        f32x16 s[4];
#pragma unroll
        for (int kb = 0; kb < 4; ++kb) { zero16(s[kb]);
#pragma unroll
            for (int ks = 0; ks < 4; ++ks) { const bf16x8 a = *(const LAS bf16x8*)(lds + L_KT + (32 * kb + l32) * 144 + (16 * ks + 8 * g) * 2); s[kb] = mfma32(a, qf[ks], s[kb]); } }
        float mx = -1e30f;
#pragma unroll
        for (int kb = 0; kb < 4; ++kb)
#pragma unroll
            for (int j = 0; j < 16; ++j) { const int n = 32 * kb + 8 * (j >> 2) + 4 * g + (j & 3); const int dist = tpos - (16 * n + 31);
                const float v = dist >= 0 ? s[kb][j] + slope2 * (float)(16 * n) : -1e30f; s[kb][j] = v; mx = fmaxf(mx, v); }
        mx = fmaxf(mx, __shfl_xor(mx, 32));
        float psum = 0.f;
#pragma unroll
        for (int kb = 0; kb < 4; ++kb)
#pragma unroll
            for (int j = 0; j < 16; ++j) { const float pv = s[kb][j] > -1e29f ? ex2(s[kb][j] - mx) : 0.f; s[kb][j] = pv; psum += pv; }
        psum += __shfl_xor(psum, 32);
        const float invl = psum > 0.f ? 1.0f / psum : 0.f;
#pragma unroll
        for (int kb = 0; kb < 4; ++kb) s[kb] *= invl;
        float prevrecv = 0.f;
#pragma unroll
        for (int kb = 0; kb < 4; ++kb)
#pragma unroll
            for (int a = 0; a < 4; ++a) {
                const float run = (s[kb][4 * a] + s[kb][4 * a + 1]) + (s[kb][4 * a + 2] + s[kb][4 * a + 3]);
                const float recv = __shfl_xor(s[kb][4 * a + 3], 32);
                const float val = run + (g ? recv : prevrecv);
                prevrecv = recv;
                IMP[(r * 64 + tl) * IMPS + 8 * kb + 2 * a + g] = val;
            }
        zero16(tot[0]); zero16(tot[1]);
        const LAS unsigned char* vb = lds + L_VT + (4 * g + ((lane & 15) >> 2)) * 192 + (16 * ((lane >> 4) & 1) + 4 * (lane & 3)) * 2;
#pragma unroll
        for (int kb = 0; kb < 4; ++kb)
#pragma unroll
            for (int kk = 0; kk < 2; ++kk) {
                const bf16x8 pb = pack8(s[kb][8 * kk], s[kb][8 * kk + 1], s[kb][8 * kk + 2], s[kb][8 * kk + 3], s[kb][8 * kk + 4], s[kb][8 * kk + 5], s[kb][8 * kk + 6], s[kb][8 * kk + 7]);
#pragma unroll
                for (int dt = 0; dt < 2; ++dt) { const bf16x8 a = vtr2(vb + (32 * kb + 16 * kk) * 192 + 64 * dt, 8 * 192); tot[dt] = mfma32(a, pb, tot[dt]); }
            }
        tot[0] *= gc; tot[1] *= gc;
    }
    __syncthreads();
    if (wid == 0) {
        float sc[32];
#pragma unroll
        for (int j = 0; j < 32; ++j) {
            const float imp = ((IMP[(0 * 64 + lane) * IMPS + j] + IMP[(1 * 64 + lane) * IMPS + j]) + IMP[(2 * 64 + lane) * IMPS + j]) + IMP[(3 * 64 + lane) * IMPS + j];
            const bool forced = (j == 0) || (j == tq) || (j == tq - 1);
            sc[j] = j <= tq ? (forced ? imp + 1.0e4f : imp) : -1e30f;
            if ((j & 3) == 3) __builtin_amdgcn_sched_barrier(0);
        }
        unsigned mask = 0u;
        for (int k = 0; k < 8; ++k) {
            float best = -3.0e38f; int idx = 0;
#pragma unroll
            for (int j = 0; j < 32; ++j) { const float v = ((mask >> j) & 1u) ? -3.0e38f : sc[j]; if (v > best) { best = v; idx = j; } }
            mask |= 1u << idx;
        }
        mask &= (tq == 31) ? 0xffffffffu : ((2u << tq) - 1u);
        SEL[lane] = mask;
        unsigned un = mask;
#pragma unroll
        for (int o = 1; o < 64; o <<= 1) un |= (unsigned)__shfl_xor((int)un, o);
        if (lane == 0) { SEL[64] = un; int c = 0; for (unsigned r_ = un; r_; r_ &= r_ - 1u) { ((LAS int*)(lds + L_SEL + 272))[c] = __ffs((int)r_) - 1; ++c; } *(LAS int*)(lds + L_SEL + 268) = c; }
    }
    __syncthreads();
    const unsigned uni = (unsigned)__builtin_amdgcn_readfirstlane((int)SEL[64]);
    const unsigned mysel = SEL[tl];
    {
        f32x16 o[2], lacc; zero16(o[0]); zero16(o[1]); zero16(lacc);
        const bf16_t* kg = PH + (size_t)(tokbase + srow) * PHW + (12 + gq) * 64 + sch * 8;
        const bf16_t* vg = PH + (size_t)(tokbase + srow) * PHW + (14 + gq) * 64 + sch * 8;
        u32x4 kA, vA, kB, vB;
        const LAS int* LIST = (const LAS int*)(lds + L_SEL + 272);
        { const int n_ = __builtin_amdgcn_readfirstlane(*(const LAS int*)(lds + L_SEL + 268));
          kA = kS0; vA = vS0; if (n_ > 1) { { const int bk_ = __builtin_amdgcn_readfirstlane(LIST[1]); kB = *(const u32x4*)(kg + (size_t)bk_ * 64 * PHW); vB = *(const u32x4*)(vg + (size_t)bk_ * 64 * PHW); } }
          *(LAS u32x4*)(lds + 0 + L_KT + srow * 144 + sch * 16) = kA; *(LAS u32x4*)(lds + 0 + L_VT + srow * 192 + sch * 16) = vA; if (n_ > 2) { { const int bk_ = __builtin_amdgcn_readfirstlane(LIST[2]); kA = *(const u32x4*)(kg + (size_t)bk_ * 64 * PHW); vA = *(const u32x4*)(vg + (size_t)bk_ * 64 * PHW); } }
          __syncthreads();
#pragma unroll 1
          for (int i_ = 0; i_ < n_; i_ += 2) {
            if (i_ + 1 < n_) { *(LAS u32x4*)(lds + L_B1 + L_KT + srow * 144 + sch * 16) = kB; *(LAS u32x4*)(lds + L_B1 + L_VT + srow * 192 + sch * 16) = vB; if (i_ + 3 < n_) { { const int bk_ = __builtin_amdgcn_readfirstlane(LIST[(i_ + 3)]); kB = *(const u32x4*)(kg + (size_t)bk_ * 64 * PHW); vB = *(const u32x4*)(vg + (size_t)bk_ * 64 * PHW); } } }
            { const int j = __builtin_amdgcn_readfirstlane(LIST[i_]); const bool rs = ((mysel >> j) & 1u) != 0u; attn_tile64<false, 64>(j == tq || __builtin_amdgcn_ballot_w64(rs) != ~0ull, lds + 0 + L_KT, 144, lds + 0 + L_VT, 192, qf, o, lacc, lane, tpos, 64 * j, slope2, 0.f, rs, 1 << 30, nullptr); }
            __syncthreads();
            if (i_ + 1 < n_) {
              if (i_ + 2 < n_) { *(LAS u32x4*)(lds + 0 + L_KT + srow * 144 + sch * 16) = kA; *(LAS u32x4*)(lds + 0 + L_VT + srow * 192 + sch * 16) = vA; if (i_ + 4 < n_) { { const int bk_ = __builtin_amdgcn_readfirstlane(LIST[(i_ + 4)]); kA = *(const u32x4*)(kg + (size_t)bk_ * 64 * PHW); vA = *(const u32x4*)(vg + (size_t)bk_ * 64 * PHW); } } }
              { const int j = __builtin_amdgcn_readfirstlane(LIST[(i_ + 1)]); const bool rs = ((mysel >> j) & 1u) != 0u; attn_tile64<false, 64>(j == tq || __builtin_amdgcn_ballot_w64(rs) != ~0ull, lds + L_B1 + L_KT, 144, lds + L_B1 + L_VT, 192, qf, o, lacc, lane, tpos, 64 * j, slope2, 0.f, rs, 1 << 30, nullptr); }
              __syncthreads();
            }
          }
        }
        const float lt = lacc[0], f = lt > 0.f ? gs / lt : 0.f;
        tot[0] += o[0] * f; tot[1] += o[1] * f;
    }
    {
        f32x16 o[2], lacc; zero16(o[0]); zero16(o[1]); zero16(lacc);
        const bf16_t* kg = PH + (size_t)(tokbase + srow) * PHW + (16 + gq) * 64 + sch * 8;
        const bf16_t* vg = PH + (size_t)(tokbase + srow) * PHW + (18 + gq) * 64 + sch * 8;
        u32x4 kA, vA, kB, vB;
        { const int n_ = tq - j0 + 1;
          kA = kW0; vA = vW0; if (n_ > 1) { kB = *(const u32x4*)(kg + (size_t)(j0 + 1) * 64 * PHW); vB = *(const u32x4*)(vg + (size_t)(j0 + 1) * 64 * PHW); }
          *(LAS u32x4*)(lds + 0 + L_KT + srow * 144 + sch * 16) = kA; *(LAS u32x4*)(lds + 0 + L_VT + srow * 192 + sch * 16) = vA; if (n_ > 2) { kA = *(const u32x4*)(kg + (size_t)(j0 + 2) * 64 * PHW); vA = *(const u32x4*)(vg + (size_t)(j0 + 2) * 64 * PHW); }
          __syncthreads();
#pragma unroll 1
          for (int i_ = 0; i_ < n_; i_ += 2) {
            if (i_ + 1 < n_) { *(LAS u32x4*)(lds + L_B1 + L_KT + srow * 144 + sch * 16) = kB; *(LAS u32x4*)(lds + L_B1 + L_VT + srow * 192 + sch * 16) = vB; if (i_ + 3 < n_) { kB = *(const u32x4*)(kg + (size_t)(j0 + (i_ + 3)) * 64 * PHW); vB = *(const u32x4*)(vg + (size_t)(j0 + (i_ + 3)) * 64 * PHW); } }
            { const int j = j0 + i_; attn_tile64<false, 64>(j == tq || j == tq - 4, lds + 0 + L_KT, 144, lds + 0 + L_VT, 192, qf, o, lacc, lane, tpos, 64 * j, slope2, 0.f, true, 256, nullptr); }
            __syncthreads();
            if (i_ + 1 < n_) {
              if (i_ + 2 < n_) { *(LAS u32x4*)(lds + 0 + L_KT + srow * 144 + sch * 16) = kA; *(LAS u32x4*)(lds + 0 + L_VT + srow * 192 + sch * 16) = vA; if (i_ + 4 < n_) { kA = *(const u32x4*)(kg + (size_t)(j0 + (i_ + 4)) * 64 * PHW); vA = *(const u32x4*)(vg + (size_t)(j0 + (i_ + 4)) * 64 * PHW); } }
              { const int j = j0 + (i_ + 1); attn_tile64<false, 64>(j == tq || j == tq - 4, lds + L_B1 + L_KT, 144, lds + L_B1 + L_VT, 192, qf, o, lacc, lane, tpos, 64 * j, slope2, 0.f, true, 256, nullptr); }
              __syncthreads();
            }
          }
        }
        const float lt = lacc[0], f = lt > 0.f ? gw / lt : 0.f;
        tot[0] += o[0] * f; tot[1] += o[1] * f;
    }
    bf16_t* op = OA + (size_t)(tokbase + tpos) * 1536 + head * 64 + 4 * g;
#pragma unroll
    for (int dt = 0; dt < 2; ++dt)
#pragma unroll
        for (int a = 0; a < 4; ++a) { u32x2 w; w.x = cvt_pk_bf16(tot[dt][4 * a], tot[dt][4 * a + 1]); w.y = cvt_pk_bf16(tot[dt][4 * a + 2], tot[dt][4 * a + 3]); *(u32x2*)(op + 32 * dt + 8 * a) = w; }
}

#ifndef ATT_REP_TYPES
#define ATT_REP_TYPES 7
#endif
#ifndef ATT_REPS
#define ATT_REPS 1
#endif
__device__ __forceinline__ void attn_phase(const Params& p, LAS unsigned char* lds, int layer, unsigned* ctr, int tid_in, int tmask = 7) {
    LAS int* uq = (LAS int*)(lds + L_UQ);
    for (;;) {
        __syncthreads();
        if (tid_in == 0) *uq = (int)atomicAdd(ctr, 1u);
        __syncthreads();
        const int u_ = __builtin_amdgcn_readfirstlane(*uq);
        if (u_ >= 3072 * ATT_REPS) break;
        const int u = u_ % 3072; if (u_ >= 3072) tmask = ATT_REP_TYPES;
        int tid = tid_in; asm volatile("" : "+v"(tid));
        const int lane = tid & 63, wid = __builtin_amdgcn_readfirstlane(tid >> 6);
        const int lv = u / 192, idx = u - lv * 192;
        if (idx < 64) { if (tmask & 1) diff_unit(p, lds, layer, idx >> 2, idx & 3, 15 - lv, tid, wid, lane); }
        else if (idx < 128) { const int k = (idx - 64) + 64 * (lv & 1); if (tmask & 2) fox_unit(p, lds, k >> 3, k & 7, 7 - (lv >> 1), tid, wid, lane); }
        else { const int k = idx - 128; if (tmask & 4) nsa_unit(p, lds, k >> 2, (k >> 1) & 1, 31 - 2 * lv - (k & 1), tid, wid, lane); }
    }
}

__device__ __forceinline__ void unpack8(const u32x4 w, float (&x)[8]) {
#pragma unroll
    for (int i = 0; i < 4; ++i) { x[2 * i] = __uint_as_float(w[i] << 16); x[2 * i + 1] = __uint_as_float(w[i] & 0xffff0000u); }
}
__device__ __forceinline__ void conv_phase(const Params& p, int layer, int tid) {
    const bf16_t* UG = (const bf16_t*)(p.ws + WS_R + R_UG); bf16_t* ACT = (bf16_t*)(p.ws + WS_R + R_ACT);
    const float* cw = p.in[19] + (size_t)layer * 3 * DFF; const float* cb = p.in[20] + (size_t)layer * DFF;
    constexpr int NCG = DFF / 8, RUN = 32, NITEM = (TC / RUN) * NCG;
    for (int it = blockIdx.x * 512 + tid; it < NITEM; it += gridDim.x * 512) {
        const int run = it / NCG, c = (it - run * NCG) * 8, t0 = run * RUN;
        float w0[8], w1[8], w2[8], bb[8];
#pragma unroll
        for (int hf = 0; hf < 2; ++hf) { const f32x4 a = *(const f32x4*)(cw + c + 4 * hf), b2 = *(const f32x4*)(cw + DFF + c + 4 * hf), c2 = *(const f32x4*)(cw + 2 * DFF + c + 4 * hf), d = *(const f32x4*)(cb + c + 4 * hf);
#pragma unroll
            for (int i = 0; i < 4; ++i) { w0[4 * hf + i] = a[i]; w1[4 * hf + i] = b2[i]; w2[4 * hf + i] = c2[i]; bb[4 * hf + i] = d[i]; } }
        const bf16_t* up = UG + (size_t)t0 * NUP + c;
        float x0[8], x1[8];
        const bool head = (t0 & (SEQ - 1)) == 0;
        { u32x4 a = (u32x4){0u, 0u, 0u, 0u}, b2 = a; if (!head) { a = *(const u32x4*)(up - 2 * NUP); b2 = *(const u32x4*)(up - NUP); } unpack8(a, x0); unpack8(b2, x1); }
#pragma unroll 1
        for (int r0 = 0; r0 < RUN; r0 += 4) {
            u32x4 uw[4], gw[4];
#pragma unroll
            for (int q = 0; q < 4; ++q) { uw[q] = *(const u32x4*)(up + (size_t)(r0 + q) * NUP); gw[q] = *(const u32x4*)(up + (size_t)(r0 + q) * NUP + DFF); }
#pragma unroll
            for (int q = 0; q < 4; ++q) {
                float x2[8], xg[8], res[8]; unpack8(uw[q], x2); unpack8(gw[q], xg);
#pragma unroll
                for (int i = 0; i < 8; ++i) { res[i] = gelu_tanh(bb[i] + w0[i] * x0[i] + w1[i] * x1[i] + w2[i] * x2[i]) * xg[i]; x0[i] = x1[i]; x1[i] = x2[i]; }
                u32x4 w; w.x = cvt_pk_bf16(res[0], res[1]); w.y = cvt_pk_bf16(res[2], res[3]); w.z = cvt_pk_bf16(res[4], res[5]); w.w = cvt_pk_bf16(res[6], res[7]);
                *(u32x4*)(ACT + (size_t)(t0 + r0 + q) * DFF + c) = w;
            }
        }
    }
}

#define XB_TMO      128
#define XB_XCNT(j)  (256  + 64 * (j))
#define XB_XSUB(j)  (1280 + 64 * (j))
#define XB_XGEN(j)  (2304 + 64 * (j))
#define XB_TOP      3328
#define XB_TOPGEN   3392
#define XCD_BAR_WORDS 3456
#define XB_SPIN_CAP (1u << 18)

__device__ __forceinline__ unsigned xb_ld(unsigned* p)              { return __hip_atomic_load(p, __ATOMIC_RELAXED, __HIP_MEMORY_SCOPE_AGENT); }
__device__ __forceinline__ unsigned xb_add(unsigned* p, unsigned v) { return __hip_atomic_fetch_add(p, v, __ATOMIC_RELAXED, __HIP_MEMORY_SCOPE_AGENT); }
__device__ __forceinline__ unsigned xb_xcc_id() { return (unsigned)__builtin_amdgcn_s_getreg((3 << 11) | 20) & 0xFu; }
#define XB_SPIN(cond, bar) do { unsigned _sp = 0; while (cond) { __builtin_amdgcn_s_sleep(1); \
    if ((++_sp & 255u) == 0u) { if (xb_ld(&(bar)[XB_TMO])) break; if (_sp > XB_SPIN_CAP) { atomicAdd(&(bar)[XB_TMO], 1u); break; } } } } while (0)

struct XcdBarrier {
    unsigned* bar; unsigned x;
    volatile LAS unsigned* st;
};

__device__ __forceinline__ XcdBarrier xcd_barrier_post(unsigned* bar, volatile LAS unsigned* st) {
    XcdBarrier b; b.bar = bar; b.x = xb_xcc_id(); b.st = st;
    if (threadIdx.x == 0) (void)xb_add(&bar[XB_XCNT(b.x)], 1u);
    return b;
}
__device__ __forceinline__ void xcd_barrier_complete(unsigned* bar, unsigned x, unsigned& nloc, unsigned& nx) {
    const unsigned G = gridDim.x * gridDim.y * gridDim.z;
    unsigned sum, cnt, mine, sp = 0u;
    for (;;) {
        sum = 0u; cnt = 0u; mine = 0u;
#pragma unroll
        for (unsigned j = 0; j < 16; ++j) { const unsigned c = xb_ld(&bar[XB_XCNT(j)]); sum += c; cnt += (c > 0u) ? 1u : 0u; mine = (j == x) ? c : mine; }
        if (sum == G) break;
        __builtin_amdgcn_s_sleep(1);
        if ((++sp & 255u) == 0u) { if (xb_ld(&bar[XB_TMO])) break; if (sp > XB_SPIN_CAP) { atomicAdd(&bar[XB_TMO], 1u); break; } }
    }
    nloc = mine > 0u ? mine : 1u; nx = cnt > 0u ? cnt : 1u;
}

__device__ __forceinline__ void xcd_barrier(const XcdBarrier& b) {
    asm volatile("s_waitcnt vmcnt(0)" ::: "memory");
    __syncthreads();
    if (threadIdx.x == 0) {
        unsigned* bar = b.bar;
        __builtin_amdgcn_s_waitcnt(0);
        unsigned nloc = b.st[0], nx = b.st[1];
        if (nloc == 0u) { xcd_barrier_complete(bar, b.x, nloc, nx); b.st[0] = nloc; b.st[1] = nx; }
        const unsigned old = xb_add(&bar[XB_XSUB(b.x)], 1u);
        const unsigned gen = old / nloc;
        if (old + 1u == (gen + 1u) * nloc) {
            __builtin_amdgcn_fence(__ATOMIC_RELEASE, "agent");
            asm volatile("s_waitcnt vmcnt(0)" ::: "memory");
            const unsigned og = xb_add(&bar[XB_TOP], 1u);
            const unsigned tg = og / nx;
            if (og + 1u == (tg + 1u) * nx) xb_add(&bar[XB_TOPGEN], 1u);
            else XB_SPIN(xb_ld(&bar[XB_TOPGEN]) == tg, bar);
            __builtin_amdgcn_fence(__ATOMIC_ACQUIRE, "agent");
            xb_add(&bar[XB_XGEN(b.x)], 1u);
            asm volatile("s_waitcnt vmcnt(0)" ::: "memory");
        } else {
            XB_SPIN(xb_ld(&bar[XB_XGEN(b.x)]) == gen, bar);
            __builtin_amdgcn_fence(__ATOMIC_ACQUIRE, "agent");
            asm volatile("s_waitcnt vmcnt(0)" ::: "memory");
        }
    }
    __syncthreads();
}

constexpr int NPH = 1 + NCHUNK * 2 * 10;
#ifndef PH_MASK
#define PH_MASK 0xfff
#endif
#define EN(k) ((PH_MASK >> (k)) & 1)
#ifndef REP_MASK
#define REP_MASK 0
#endif

#ifndef GEMM_SP2
#define GEMM_SP2 true
#endif
#ifndef GEMM_ALIGN
#define GEMM_ALIGN true
#endif

__global__ void __launch_bounds__(512) fwd_megakernel(Params p) {
    extern __shared__ __attribute__((aligned(16))) unsigned char smem[];
    LAS unsigned char* lds = (LAS unsigned char*)smem;
    cg::grid_group grid = cg::this_grid();
    volatile LAS unsigned* xst = (volatile LAS unsigned*)(lds + 131072 + 512);
    if (threadIdx.x < 2) xst[threadIdx.x] = 0u;
    __syncthreads();
    const XcdBarrier xbar = xcd_barrier_post((unsigned*)(p.ws + WS_CTL + CTL_BAR), xst);
    for (int ph = p.ph_lo; ph < p.ph_hi; ++ph) {
        int tid0 = threadIdx.x; asm volatile("" : "+v"(tid0));
        unsigned char* ws = p.ws; asm volatile("" : "+s"(ws));
        if (ph == 0) { if (EN(10)) p0_prologue(p, lds, tid0); }
        else {
            const int q = ph - 1, chunk = q / 20, layer = (q / 10) & 1, k = q % 10;
            unsigned char* wb = ws + WS_W + layer * LW;
            bf16_t* XN = (bf16_t*)(ws + WS_XN);
            float* fout = p.out + (size_t)chunk * TC * DM; const float* xin = p.in[0] + (size_t)chunk * TC * DM; bf16_t* HB = (bf16_t*)(ws + WS_HB);
            pg8::StaticOrder S;
            for (int rep = 0; rep <= ((REP_MASK >> k) & 1); ++rep) {
            if (rep) xcd_barrier(xbar);
            int tid = tid0; asm volatile("" : "+v"(tid));
            const int lane = tid & 63, wid = __builtin_amdgcn_readfirstlane(tid >> 6);
            if (k == 0) { if (EN(0)) { if (layer == 0) norm_phase<false>(xin, p.in[1], XN, wid, lane); else norm_phase<true>(HB, p.in[1] + DM, XN, wid, lane); } }
            else if (k == 1) { if (EN(1)) {
                pg8::Gemm g{XN, (const bf16_t*)(wb + W_IN), TC, NINP, 1024}; S.init(TC, NINP, gridDim.x, blockIdx.x);
                pg8::EpiIn E{(bf16_t*)(ws + WS_R + R_PH), (bf16_t*)(ws + WS_R + R_MG), (float*)(ws + WS_R + R_GT), p.in[3] + layer * 64, p.in[4] + layer * 192, p.in[8] + layer * 64, p.in[9] + layer * 64, p.in[12] + layer * 64, p.in[13] + layer * 64};
                pg8::gemm_phase<pg8::EpiIn, pg8::StaticOrder, GEMM_ALIGN, GEMM_SP2>(lds, g, S, E); }
            }
            else if (k == 2) { if (EN(2)) prep_phase(p, lds, layer, wid, lane); }
            else if (k == 3) { if (EN(3)) attn_phase(p, lds, layer, (unsigned*)(ws + WS_CTL) + 16 * (chunk * 2 + layer) + 8 * rep, tid, 7); }
            else if (k == 4) { if (EN(4)) {
                S.init(TC, 1024, gridDim.x, blockIdx.x);
                pg8::Gemm g{(const bf16_t*)(ws + WS_R + R_OA), (const bf16_t*)(wb + W_BR), TC, 1024, 1536};
                pg8::EpiMerge E{(const bf16_t*)(ws + WS_R + R_MG), XN}; pg8::gemm_phase<pg8::EpiMerge, pg8::StaticOrder, GEMM_ALIGN, GEMM_SP2>(lds, g, S, E); }
            }
            else if (k == 5) { if (EN(5)) {
                pg8::Gemm g{XN, (const bf16_t*)(wb + W_O), TC, 1024, 1024}; S.init(TC, 1024, gridDim.x, blockIdx.x);
                if (layer == 0) { pg8::EpiRes<false, true> E{xin, HB}; pg8::gemm_phase<pg8::EpiRes<false, true>, pg8::StaticOrder, GEMM_ALIGN, GEMM_SP2>(lds, g, S, E); }
                else { pg8::EpiRes<true, true> E{HB, HB}; pg8::gemm_phase<pg8::EpiRes<true, true>, pg8::StaticOrder, GEMM_ALIGN, GEMM_SP2>(lds, g, S, E); } }
            }
            else if (k == 6) { if (EN(6)) norm_phase<true>(HB, p.in[17] + layer * DM, XN, wid, lane); }
            else if (k == 7) { if (EN(7)) {
                pg8::Gemm g{XN, (const bf16_t*)(wb + W_UP), TC, NUP, 1024}; S.init(TC, NUP, gridDim.x, blockIdx.x);
                pg8::EpiStore E{(bf16_t*)(ws + WS_R + R_UG), NUP}; pg8::gemm_phase<pg8::EpiStore, pg8::StaticOrder, GEMM_ALIGN, GEMM_SP2>(lds, g, S, E); }
            }
            else if (k == 8) { if (EN(8)) conv_phase(p, layer, tid); }
            else { if (EN(9)) {
                pg8::Gemm g{(const bf16_t*)(ws + WS_R + R_ACT), (const bf16_t*)(wb + W_DN), TC, 1024, DFF}; S.init(TC, 1024, gridDim.x, blockIdx.x);
                if (layer == 0) { pg8::EpiRes<true, true> E{HB, HB}; pg8::gemm_phase<pg8::EpiRes<true, true>, pg8::StaticOrder, GEMM_ALIGN, GEMM_SP2>(lds, g, S, E); }
                else { pg8::EpiRes<true, false> E{HB, fout}; pg8::gemm_phase<pg8::EpiRes<true, false>, pg8::StaticOrder, GEMM_ALIGN, GEMM_SP2>(lds, g, S, E); } }
            }
            }
        }
        if (ph + 1 < p.ph_hi) { if (p.ph_lo < 0) grid.sync(); else xcd_barrier(xbar); }
    }
}
}

extern "C" void kernel_launch(void* const* d_in, const int* in_sizes, int n_in, void* d_out, int out_size, void* d_ws, size_t ws_size, hipStream_t stream) {
    static int grid = 0;
    if (grid == 0) {
        if (n_in != 22 || ws_size < mk::WS_END) { fprintf(stderr, "kernel_launch: unexpected n_in %d or ws %zu (< %zu)\n", n_in, ws_size, (size_t)mk::WS_END); grid = -1; return; }
        int dev = 0, cus = 0, per_cu = 0;
        hipGetDevice(&dev); hipDeviceGetAttribute(&cus, hipDeviceAttributeMultiprocessorCount, dev);
        if (hipFuncSetAttribute((const void*)mk::fwd_megakernel, hipFuncAttributeMaxDynamicSharedMemorySize, mk::LDS_BYTES) != hipSuccess) { fprintf(stderr, "hipFuncSetAttribute failed\n"); grid = -1; return; }
        if (hipOccupancyMaxActiveBlocksPerMultiprocessor(&per_cu, (const void*)mk::fwd_megakernel, 512, mk::LDS_BYTES) != hipSuccess || per_cu < 1) { fprintf(stderr, "occupancy query: %d\n", per_cu); per_cu = 1; }
        (void)hipGetLastError();
        grid = cus * per_cu;
    }
    if (grid < 0) return;
    hipMemsetAsync((char*)d_ws + mk::WS_CTL, 0, mk::CTL_BYTES, stream);
    mk::Params p{};
    for (int i = 0; i < 22; ++i) p.in[i] = (const float*)d_in[i];
    p.out = (float*)d_out; p.ws = (unsigned char*)d_ws; p.ph_lo = 0; p.ph_hi = mk::NPH;
    void* args[] = {&p};
    hipError_t e = hipLaunchCooperativeKernel((void*)mk::fwd_megakernel, dim3(grid), dim3(512), args, mk::LDS_BYTES, stream);
    if (e != hipSuccess) fprintf(stderr, "cooperative launch failed: %s (grid %d)\n", hipGetErrorString(e), grid);
}
```

```cpp
#include <hip/hip_runtime.h>
#include <hip/hip_cooperative_groups.h>
#include <cstdio>
#include <cstdint>
namespace cg = cooperative_groups;
namespace pg8 {
#define PG8_LAS __attribute__((address_space(3)))
typedef unsigned short bf16_t;
typedef short bf16x8 __attribute__((ext_vector_type(8)));
typedef float f32x4 __attribute__((ext_vector_type(4)));
typedef unsigned u32x4 __attribute__((ext_vector_type(4)));
constexpr int BM = 256, BK = 64, HALF = 128, HTB = HALF * BK * 2  , STAGE_BYTES = 8 * HTB, NXCD = 8, WGM = 8;

__host__ __device__ __forceinline__ int lds_byte(int r, int c) { const int st = (r >> 4) * 2 + (c >> 5), rr = r & 15, cc = c & 31, ob = rr * 64 + cc * 2; return st * 1024 + (ob ^ (((ob >> 9) & 1) << 5)); }
__host__ __device__ __forceinline__ void stage_rc(int b, int& R, int& C) { const int st = b / 1024, sb = b % 1024, swz = sb ^ (((sb >> 9) & 1) << 5); R = (st >> 1) * 16 + swz / 64; C = (st & 1) * 32 + (swz % 64) / 2; }
__host__ __device__ __forceinline__ int perm32(int rho) { const int n = rho >> 4, i = rho & 15; return 8 * (i >> 2) + 4 * n + (i & 3); }

struct Unit { int pm, pn; };
struct Gemm { const bf16_t* A; const bf16_t* Bt; int M, N, K; };

struct StaticOrder {
    int nM, nN, nwg, G, c;
    __host__ __device__ void init(int M, int N, int G_, int c_) { nM = M / BM; nN = N / BM; nwg = nM * nN; G = G_; c = c_; }
    __host__ __device__ bool next(int i, Unit& u) const {
        const long L = (long)i * G + c; if (L >= nwg) return false;
        int wgid = (int)L; { const int q = nwg / NXCD, r = nwg % NXCD, xcd = wgid % NXCD, off = wgid / NXCD; wgid = (xcd < r ? xcd * (q + 1) : r * (q + 1) + (xcd - r) * q) + off; }
        const int nig = WGM * nN, gid = wgid / nig, fm = gid * WGM, gsz = (nM - fm) < WGM ? (nM - fm) : WGM;
        u.pm = fm + ((wgid % nig) % gsz); u.pn = (wgid % nig) / gsz; return true;
    }
    __device__ __forceinline__ void a_ready(const Unit&) const {}
    __device__ __forceinline__ void done(const Unit&) const {}
};
typedef float f32x2c_t __attribute__((ext_vector_type(2))); typedef __bf16 bf16x2c_t __attribute__((ext_vector_type(2)));
__device__ __forceinline__ unsigned cvt_pk_bf16(float lo, float hi) { const f32x2c_t v = {lo, hi}; const bf16x2c_t r = __builtin_convertvector(v, bf16x2c_t); return __builtin_bit_cast(unsigned, r); }
typedef unsigned u32x2 __attribute__((ext_vector_type(2)));
__device__ __forceinline__ float sigmoidf_(float x) { return __builtin_amdgcn_rcpf(1.0f + __builtin_amdgcn_exp2f(-1.4426950408889634f * x)); }
__device__ __forceinline__ float bf2f_(unsigned short v) { return __uint_as_float(((unsigned)v) << 16); }

struct EpiIn {
    static constexpr bool PERM = true, AFTER_DRAIN = false, HOOK = false;
    bf16_t* PH; bf16_t* MG; float* GT;
    const float *nsa_q_g, *nsa_k_g, *diff_q_g, *diff_k_g, *fox_q_g, *fox_k_g;
    __device__ __forceinline__ void operator()(const f32x4 (&acc)[2][2][4][2], const Unit& u, int wr, int wc, int fr, int fq) const {
        const int row0 = u.pm * BM + wr * 64 + fr;
        if (u.pn < 17) {
            const int head = 4 * u.pn + wc;
            const float* gp = nullptr; float sc = 1.0f;
            if (head < 8) { gp = nsa_q_g; sc = 0.125f * 1.4426950408889634f; }
            else if (head < 20) { const int hh = head - 8, br = hh >> 2, kv = (hh >> 1) & 1; if (kv == 0 && br >= 1) gp = nsa_k_g + br * 64; }
            else if (head < 28) { gp = diff_q_g; sc = 0.125f * 1.4426950408889634f; }
            else if (head < 36) { gp = diff_k_g; }
            else if (head < 44) { }
            else if (head < 52) { gp = fox_q_g; sc = 0.125f * 1.4426950408889634f; }
            else if (head < 60) { gp = fox_k_g; }
            f32x4 gv[2][2];
#pragma unroll
            for (int bj = 0; bj < 2; ++bj)
#pragma unroll
                for (int n = 0; n < 2; ++n) gv[bj][n] = gp ? *(const f32x4*)(gp + 32 * bj + 8 * fq + 4 * n) : (f32x4){1.f, 1.f, 1.f, 1.f};
#pragma unroll
            for (int ai = 0; ai < 2; ++ai)
#pragma unroll
                for (int m = 0; m < 4; ++m) {
                    float r = 1.0f;
                    if (gp) {
                        float ss = 0.f;
#pragma unroll
                        for (int bj = 0; bj < 2; ++bj)
#pragma unroll
                            for (int n = 0; n < 2; ++n) { const f32x4 x = acc[ai][bj][m][n]; ss += (x[0] * x[0] + x[1] * x[1]) + (x[2] * x[2] + x[3] * x[3]); }
                        ss += __shfl_xor(ss, 16); ss += __shfl_xor(ss, 32);
                        r = rsqrtf(ss * (1.0f / 64.0f) + 1e-6f) * sc;
                    }
                    bf16_t* rowp = PH + (size_t)(row0 + ai * HALF + m * 16) * 4352 + head * 64 + 8 * fq;
#pragma unroll
                    for (int bj = 0; bj < 2; ++bj) { const f32x4 v0 = acc[ai][bj][m][0] * r * gv[bj][0], v1 = acc[ai][bj][m][1] * r * gv[bj][1];
                        u32x4 w; w.x = cvt_pk_bf16(v0[0], v0[1]); w.y = cvt_pk_bf16(v0[2], v0[3]); w.z = cvt_pk_bf16(v1[0], v1[1]); w.w = cvt_pk_bf16(v1[2], v1[3]); *(u32x4*)(rowp + 32 * bj) = w; }
                }
        } else if (u.pn < 29) {
            const int col0 = (u.pn - 17) * BM + wc * 32 + 8 * fq;
#pragma unroll
            for (int ai = 0; ai < 2; ++ai)
#pragma unroll
                for (int m = 0; m < 4; ++m) {
                    bf16_t* rowp = MG + (size_t)(row0 + ai * HALF + m * 16) * 3072 + col0;
#pragma unroll
                    for (int bj = 0; bj < 2; ++bj) { const f32x4 v0 = acc[ai][bj][m][0], v1 = acc[ai][bj][m][1];
                        u32x4 w; w.x = cvt_pk_bf16(sigmoidf_(v0[0]), sigmoidf_(v0[1])); w.y = cvt_pk_bf16(sigmoidf_(v0[2]), sigmoidf_(v0[3])); w.z = cvt_pk_bf16(sigmoidf_(v1[0]), sigmoidf_(v1[1])); w.w = cvt_pk_bf16(sigmoidf_(v1[2]), sigmoidf_(v1[3]));
                        *(u32x4*)(rowp + bj * HALF) = w; }
                }
        } else {
            if (wc == 0) {
#pragma unroll
                for (int ai = 0; ai < 2; ++ai)
#pragma unroll
                    for (int m = 0; m < 4; ++m) {
                        float* rowp = GT + (size_t)(row0 + ai * HALF + m * 16) * 32 + 8 * fq;
#pragma unroll
                        for (int n = 0; n < 2; ++n) *(f32x4*)(rowp + 4 * n) = acc[ai][0][m][n];
                    }
            }
        }
    }
};

struct EpiMerge {
    static constexpr bool PERM = true, AFTER_DRAIN = false, HOOK = true;
    const bf16_t* MG; bf16_t* XN;
    __device__ __forceinline__ void gate8(const bf16_t* p, f32x4& g0, f32x4& g1) const {
        const u32x4 w = *(const u32x4*)p;
        g0[0] = __uint_as_float(w.x << 16); g0[1] = __uint_as_float(w.x & 0xffff0000u); g0[2] = __uint_as_float(w.y << 16); g0[3] = __uint_as_float(w.y & 0xffff0000u);
        g1[0] = __uint_as_float(w.z << 16); g1[1] = __uint_as_float(w.z & 0xffff0000u); g1[2] = __uint_as_float(w.w << 16); g1[3] = __uint_as_float(w.w & 0xffff0000u);
    }
    __device__ __forceinline__ void cvt8(const u32x4 w, f32x4& g0, f32x4& g1) const {
        g0[0] = __uint_as_float(w.x << 16); g0[1] = __uint_as_float(w.x & 0xffff0000u); g0[2] = __uint_as_float(w.y << 16); g0[3] = __uint_as_float(w.y & 0xffff0000u);
        g1[0] = __uint_as_float(w.z << 16); g1[1] = __uint_as_float(w.z & 0xffff0000u); g1[2] = __uint_as_float(w.w << 16); g1[3] = __uint_as_float(w.w & 0xffff0000u);
    }
    __device__ __forceinline__ void hook(f32x4 (&acc)[2][2][4][2], const Unit& u, int seg, int wr, int wc, int fr_, int fq_) const {
        int fr = fr_, fq = fq_; asm volatile("" : "+v"(fr), "+v"(fq));
        const int row0 = u.pm * BM + wr * 64 + fr, col0 = u.pn * BM + wc * 32 + 8 * fq;
#pragma unroll
        for (int ai = 0; ai < 2; ++ai) {
            u32x4 wa[4][2], wb[4][2];
#pragma unroll
            for (int m = 0; m < 4; ++m) {
                const bf16_t* gp = MG + (size_t)(row0 + ai * HALF + m * 16) * 3072 + (seg - 1) * 1024 + col0;
#pragma unroll
                for (int bj = 0; bj < 2; ++bj) { wa[m][bj] = *(const u32x4*)(gp + bj * HALF); wb[m][bj] = *(const u32x4*)(gp + 1024 + bj * HALF); }
            }
            __builtin_amdgcn_sched_barrier(0);
#pragma unroll
            for (int m = 0; m < 4; ++m)
#pragma unroll
                for (int bj = 0; bj < 2; ++bj) {
                    f32x4 a0, a1, b0, b1; cvt8(wa[m][bj], a0, a1); cvt8(wb[m][bj], b0, b1);
#pragma unroll
                    for (int i = 0; i < 4; ++i) { acc[ai][bj][m][0][i] *= a0[i] * __builtin_amdgcn_rcpf(b0[i]); acc[ai][bj][m][1][i] *= a1[i] * __builtin_amdgcn_rcpf(b1[i]); }
                }
            __builtin_amdgcn_sched_barrier(0);
        }
    }
    __device__ __forceinline__ void operator()(const f32x4 (&acc)[2][2][4][2], const Unit& u, int wr, int wc, int fr, int fq) const {
        const int row0 = u.pm * BM + wr * 64 + fr, col0 = u.pn * BM + wc * 32 + 8 * fq;
#pragma unroll
        for (int ai = 0; ai < 2; ++ai) {
            u32x4 wg[4][2];
#pragma unroll
            for (int m = 0; m < 4; ++m)
#pragma unroll
                for (int bj = 0; bj < 2; ++bj) wg[m][bj] = *(const u32x4*)(MG + (size_t)(row0 + ai * HALF + m * 16) * 3072 + 2048 + col0 + bj * HALF);
            __builtin_amdgcn_sched_barrier(0);
#pragma unroll
            for (int m = 0; m < 4; ++m) {
                const size_t row = (size_t)(row0 + ai * HALF + m * 16);
#pragma unroll
                for (int bj = 0; bj < 2; ++bj) {
                    f32x4 g0, g1; cvt8(wg[m][bj], g0, g1);
                    const f32x4 v0 = acc[ai][bj][m][0] * g0, v1 = acc[ai][bj][m][1] * g1;
                    u32x4 w; w.x = cvt_pk_bf16(v0[0], v0[1]); w.y = cvt_pk_bf16(v0[2], v0[3]); w.z = cvt_pk_bf16(v1[0], v1[1]); w.w = cvt_pk_bf16(v1[2], v1[3]);
                    *(u32x4*)(XN + row * 1024 + col0 + bj * HALF) = w;
                }
            }
        }
    }
};

template <bool BASE_BF16, bool OUT_BF16> struct EpiRes {
    static constexpr bool PERM = true, AFTER_DRAIN = false, HOOK = false;
    const void* base; void* out;
    __device__ __forceinline__ void operator()(const f32x4 (&acc)[2][2][4][2], const Unit& u, int wr, int wc, int fr, int fq) const {
        const int row0 = u.pm * BM + wr * 64 + fr, col0 = u.pn * BM + wc * 32 + 8 * fq;
#pragma unroll
        for (int ai = 0; ai < 2; ++ai) {
            f32x4 b0[4][2], b1[4][2];
#pragma unroll
            for (int m = 0; m < 4; ++m) {
                const size_t off = (size_t)(row0 + ai * HALF + m * 16) * 1024 + col0;
#pragma unroll
                for (int bj = 0; bj < 2; ++bj) {
                    if (BASE_BF16) { const u32x4 w = *(const u32x4*)((const bf16_t*)base + off + bj * HALF);
                        b0[m][bj][0] = __uint_as_float(w.x << 16); b0[m][bj][1] = __uint_as_float(w.x & 0xffff0000u); b0[m][bj][2] = __uint_as_float(w.y << 16); b0[m][bj][3] = __uint_as_float(w.y & 0xffff0000u);
                        b1[m][bj][0] = __uint_as_float(w.z << 16); b1[m][bj][1] = __uint_as_float(w.z & 0xffff0000u); b1[m][bj][2] = __uint_as_float(w.w << 16); b1[m][bj][3] = __uint_as_float(w.w & 0xffff0000u); }
                    else { b0[m][bj] = *(const f32x4*)((const float*)base + off + bj * HALF); b1[m][bj] = *(const f32x4*)((const float*)base + off + bj * HALF + 4); }
                }
            }
            __builtin_amdgcn_sched_barrier(0);
#pragma unroll
            for (int m = 0; m < 4; ++m) {
                const size_t off = (size_t)(row0 + ai * HALF + m * 16) * 1024 + col0;
#pragma unroll
                for (int bj = 0; bj < 2; ++bj) {
                    const f32x4 v0 = b0[m][bj] + acc[ai][bj][m][0], v1 = b1[m][bj] + acc[ai][bj][m][1];
                    if (OUT_BF16) { u32x4 w; w.x = cvt_pk_bf16(v0[0], v0[1]); w.y = cvt_pk_bf16(v0[2], v0[3]); w.z = cvt_pk_bf16(v1[0], v1[1]); w.w = cvt_pk_bf16(v1[2], v1[3]); *(u32x4*)((bf16_t*)out + off + bj * HALF) = w; }
                    else { *(f32x4*)((float*)out + off + bj * HALF) = v0; *(f32x4*)((float*)out + off + bj * HALF + 4) = v1; }
                }
            }
        }
    }
};

struct EpiStore {
    static constexpr bool PERM = true, AFTER_DRAIN = false, HOOK = false;
    bf16_t* O; int ldc;
    __device__ __forceinline__ void operator()(const f32x4 (&acc)[2][2][4][2], const Unit& u, int wr, int wc, int fr, int fq) const {
        const int row0 = u.pm * BM + wr * 64 + fr, col0 = u.pn * BM + wc * 32 + 8 * fq;
#pragma unroll
        for (int ai = 0; ai < 2; ++ai)
#pragma unroll
            for (int m = 0; m < 4; ++m) {
                bf16_t* rowp = O + (size_t)(row0 + ai * HALF + m * 16) * ldc + col0;
#pragma unroll
                for (int bj = 0; bj < 2; ++bj) { const f32x4 v0 = acc[ai][bj][m][0], v1 = acc[ai][bj][m][1];
                    u32x4 w; w.x = cvt_pk_bf16(v0[0], v0[1]); w.y = cvt_pk_bf16(v0[2], v0[3]); w.z = cvt_pk_bf16(v1[0], v1[1]); w.w = cvt_pk_bf16(v1[2], v1[3]); *(u32x4*)(rowp + bj * HALF) = w; }
            }
    }
};

template <class Epi, class Sched, bool ALIGN_EPI = false, bool SP2 = false>
__device__ __forceinline__ void gemm_phase(PG8_LAS unsigned char* lds, const Gemm g, const Sched& S, const Epi& E) {
    int tid_l = threadIdx.x; asm volatile("" : "+v"(tid_l));
    const int tid = tid_l, wid = __builtin_amdgcn_readfirstlane(tid >> 6), lane = tid & 63, wr = wid >> 2, wc = wid & 3, fr = lane & 15, fq = lane >> 4;
    const int K = g.K, nt = K / BK;
    unsigned voffA[2], voffB[2];
#pragma unroll
    for (int i = 0; i < 2; ++i) { int R, C; stage_rc(tid * 16 + i * 8192, R, C); const int Rb = Epi::PERM ? ((R & ~31) + perm32(R & 31)) : R;
        voffA[i] = (unsigned)(R * K + C) * 2u; voffB[i] = (unsigned)(Rb * K + C) * 2u; }
    const size_t kstep = (size_t)(BK * 2);
    const size_t hstep = (size_t)HALF * K * 2;
    const size_t tstep = 2 * hstep;
    const unsigned ldsw = (unsigned)wid * 1024u;
    const int aoff = lds_byte(wr * 64 + fr, fq * 8), boff = lds_byte(wc * 32 + fr, fq * 8);
#define PG8_SA(b, h) (((b) * 2 + (h)) * HTB)
#define PG8_SB(b, h) ((4 + (b) * 2 + (h)) * HTB)
#define PG8_STAGE(bufoff, gbase, voff) do { _Pragma("unroll") for (int _i = 0; _i < 2; ++_i) \
        __builtin_amdgcn_global_load_lds((const unsigned*)((const char*)(gbase) + (voff)[_i]), (PG8_LAS unsigned*)(lds + (bufoff) + ldsw + _i * 8192), 16, 0, 0); } while (0)
#define PG8_LDA(dst, b, h) do { _Pragma("unroll") for (int m = 0; m < 4; ++m) _Pragma("unroll") for (int k = 0; k < 2; ++k) dst[m][k] = *(const PG8_LAS bf16x8*)(lds + PG8_SA(b, h) + aoff + m * 2048 + k * 1024); } while (0)
#define PG8_LDB(dst, b, h) do { _Pragma("unroll") for (int n = 0; n < 2; ++n) _Pragma("unroll") for (int k = 0; k < 2; ++k) dst[n][k] = *(const PG8_LAS bf16x8*)(lds + PG8_SB(b, h) + boff + n * 2048 + k * 1024); } while (0)
#define PG8_MMA(ai, bj, At, Bt) do { __builtin_amdgcn_s_setprio(1); _Pragma("unroll") for (int m = 0; m < 4; ++m) _Pragma("unroll") for (int n = 0; n < 2; ++n) _Pragma("unroll") for (int k = 0; k < 2; ++k) \
        acc[ai][bj][m][n] = __builtin_amdgcn_mfma_f32_16x16x32_bf16(Bt[n][k], At[m][k], acc[ai][bj][m][n], 0, 0, 0); __builtin_amdgcn_s_setprio(0); } while (0)
#define PG8_WAIT_V(n) asm volatile("s_waitcnt vmcnt(" #n ")" ::: "memory")
#define PG8_WAIT_L(n) asm volatile("s_waitcnt lgkmcnt(" #n ")" ::: "memory")
#define PG8_BAR __builtin_amdgcn_s_barrier()
#define PG8_SCHED __builtin_amdgcn_sched_barrier(0)
    Unit cur, nxt; int ui = 0;
    if (!S.next(0, cur)) return;
    f32x4 acc[2][2][4][2];
#pragma unroll
    for (int a = 0; a < 2; ++a)
#pragma unroll
        for (int b = 0; b < 2; ++b)
#pragma unroll
            for (int m = 0; m < 4; ++m)
#pragma unroll
                for (int n = 0; n < 2; ++n) acc[a][b][m][n] = (f32x4){0.f, 0.f, 0.f, 0.f};
    bf16x8 At[4][2], B0[2][2], B1[2][2];
    const char* cA = (const char*)g.A + (size_t)cur.pm * tstep; const char* cB = (const char*)g.Bt + (size_t)cur.pn * tstep;
    S.a_ready(cur);
    if constexpr (SP2) {
        PG8_STAGE(PG8_SB(0, 0), cB, voffB); PG8_STAGE(PG8_SB(0, 1), cB + hstep, voffB); PG8_STAGE(PG8_SA(0, 0), cA, voffA); PG8_STAGE(PG8_SA(0, 1), cA + hstep, voffA);
        if (wr == 1) PG8_BAR;
        PG8_WAIT_V(2); PG8_BAR;
        PG8_STAGE(PG8_SB(1, 0), cB + kstep, voffB); PG8_STAGE(PG8_SA(1, 0), cA + kstep, voffA); PG8_STAGE(PG8_SB(1, 1), cB + hstep + kstep, voffB);
        PG8_WAIT_V(6); PG8_BAR;
    } else {
        PG8_STAGE(PG8_SB(0, 0), cB, voffB); PG8_STAGE(PG8_SA(0, 0), cA, voffA); PG8_STAGE(PG8_SB(0, 1), cB + hstep, voffB); PG8_STAGE(PG8_SA(0, 1), cA + hstep, voffA);
        if (wr == 1) PG8_BAR;
        PG8_WAIT_V(4); PG8_BAR;
        PG8_STAGE(PG8_SB(1, 0), cB + kstep, voffB); PG8_STAGE(PG8_SA(1, 0), cA + kstep, voffA); PG8_STAGE(PG8_SB(1, 1), cB + hstep + kstep, voffB);
        PG8_WAIT_V(6); PG8_BAR;
    }
    for (;;) {
        const bool has_next = S.next(ui + 1, nxt);
        const char* nA = has_next ? (const char*)g.A + (size_t)nxt.pm * tstep : cA; const char* nB = has_next ? (const char*)g.Bt + (size_t)nxt.pn * tstep : cB;
        const int nseg = Epi::HOOK ? 3 : 1, segt = nt / nseg;
        for (int seg = 0; seg < nseg; ++seg) {
        if constexpr (Epi::HOOK) { if (seg > 0) { __builtin_amdgcn_sched_barrier(0); E.hook(acc, cur, seg, wr, wc, fr, fq); __builtin_amdgcn_sched_barrier(0); } }
        for (int t = seg * segt; t < (seg + 1) * segt; t += 2) {
            const bool last = (t == nt - 2);
            const char* a1 = cA + (size_t)(t + 1) * kstep;
            const char* a2 = last ? nA : cA + (size_t)(t + 2) * kstep; const char* b2 = last ? nB : cB + (size_t)(t + 2) * kstep;
            const char* a3 = a2 + kstep; const char* b3 = b2 + kstep;
            if (last && has_next) S.a_ready(nxt);
            if constexpr (SP2) {
            PG8_LDB(B0, 0, 0); PG8_LDB(B1, 0, 1); PG8_SCHED; PG8_LDA(At, 0, 0); PG8_STAGE(PG8_SA(1, 1), a1 + hstep, voffA);
            PG8_WAIT_V(8); PG8_WAIT_L(0); PG8_BAR; PG8_MMA(0, 0, At, B0); PG8_MMA(0, 1, At, B1); PG8_BAR; PG8_SCHED;
            PG8_LDA(At, 0, 1); PG8_STAGE(PG8_SB(0, 0), b2, voffB); PG8_STAGE(PG8_SB(0, 1), b2 + hstep, voffB); PG8_STAGE(PG8_SA(0, 0), a2, voffA);
            PG8_WAIT_V(8); PG8_WAIT_L(0); PG8_BAR; PG8_MMA(1, 0, At, B0); PG8_MMA(1, 1, At, B1); PG8_BAR; PG8_SCHED;
            PG8_LDB(B0, 1, 0); PG8_LDB(B1, 1, 1); PG8_SCHED; PG8_LDA(At, 1, 0); PG8_STAGE(PG8_SA(0, 1), a2 + hstep, voffA);
            PG8_WAIT_V(8); PG8_WAIT_L(0); PG8_BAR; PG8_MMA(0, 0, At, B0); PG8_MMA(0, 1, At, B1); PG8_BAR; PG8_SCHED;
            PG8_LDA(At, 1, 1); PG8_STAGE(PG8_SB(1, 0), b3, voffB); PG8_STAGE(PG8_SB(1, 1), b3 + hstep, voffB); PG8_STAGE(PG8_SA(1, 0), a3, voffA);
            PG8_WAIT_V(8); PG8_WAIT_L(0); PG8_BAR; PG8_MMA(1, 0, At, B0); PG8_MMA(1, 1, At, B1); PG8_BAR; PG8_SCHED;
            } else {
            PG8_LDB(B0, 0, 0); PG8_SCHED; PG8_LDA(At, 0, 0); PG8_STAGE(PG8_SA(1, 1), a1 + hstep, voffA);
            PG8_WAIT_L(8); PG8_BAR; PG8_WAIT_L(0); PG8_MMA(0, 0, At, B0); PG8_BAR; PG8_SCHED;
            PG8_LDB(B1, 0, 1); PG8_STAGE(PG8_SB(0, 0), b2, voffB);
            PG8_BAR; PG8_WAIT_L(0); PG8_MMA(0, 1, At, B1); PG8_BAR;
            PG8_LDA(At, 0, 1); PG8_STAGE(PG8_SA(0, 0), a2, voffA);
            PG8_BAR; PG8_WAIT_L(0); PG8_MMA(1, 0, At, B0); PG8_BAR; PG8_SCHED;
            PG8_STAGE(PG8_SB(0, 1), b2 + hstep, voffB);
            PG8_WAIT_V(6); PG8_BAR; PG8_MMA(1, 1, At, B1); PG8_BAR;
            PG8_LDB(B0, 1, 0); PG8_SCHED; PG8_LDA(At, 1, 0); PG8_STAGE(PG8_SA(0, 1), a2 + hstep, voffA);
            PG8_WAIT_L(8); PG8_BAR; PG8_WAIT_L(0); PG8_MMA(0, 0, At, B0); PG8_BAR; PG8_SCHED;
            PG8_LDB(B1, 1, 1); PG8_STAGE(PG8_SB(1, 0), b3, voffB);
            PG8_BAR; PG8_WAIT_L(0); PG8_MMA(0, 1, At, B1); PG8_BAR;
            PG8_LDA(At, 1, 1); PG8_STAGE(PG8_SA(1, 0), a3, voffA);
            PG8_BAR; PG8_WAIT_L(0); PG8_MMA(1, 0, At, B0); PG8_BAR; PG8_SCHED;
            PG8_STAGE(PG8_SB(1, 1), b3 + hstep, voffB);
            PG8_WAIT_V(6); PG8_BAR; PG8_MMA(1, 1, At, B1); PG8_BAR;
            }
        }
        }
        if constexpr (ALIGN_EPI) { if (wr == 0) PG8_BAR; }
        if constexpr (!Epi::AFTER_DRAIN) { E(acc, cur, wr, wc, fr, fq); S.done(cur); }
        if (!has_next) break;
#pragma unroll
        for (int a = 0; a < 2; ++a)
#pragma unroll
            for (int b = 0; b < 2; ++b)
#pragma unroll
                for (int m = 0; m < 4; ++m)
#pragma unroll
                    for (int n = 0; n < 2; ++n) acc[a][b][m][n] = (f32x4){0.f, 0.f, 0.f, 0.f};
        cur = nxt; cA = nA; cB = nB; ++ui;
        if constexpr (ALIGN_EPI) { if (wr == 1) PG8_BAR; }
    }
    PG8_WAIT_V(0);
    if constexpr (!ALIGN_EPI) { if (wr == 0) PG8_BAR; }
    PG8_BAR;
    if constexpr (Epi::AFTER_DRAIN) { E.fused(acc, cur, wr, wc, fr, fq, lds, wid, lane); S.done(cur); }
#undef PG8_SA
#undef PG8_SB
#undef PG8_STAGE
#undef PG8_LDA
#undef PG8_LDB
#undef PG8_MMA
#undef PG8_WAIT_V
#undef PG8_WAIT_L
#undef PG8_BAR
#undef PG8_SCHED
}
}

namespace mk {
using pg8::bf16_t; using pg8::bf16x8; using pg8::f32x4; using pg8::cvt_pk_bf16;
#define LAS __attribute__((address_space(3)))
typedef float f32x16 __attribute__((ext_vector_type(16)));
typedef short v4i16 __attribute__((ext_vector_type(4)));
typedef unsigned u32x2 __attribute__((ext_vector_type(2)));
typedef unsigned u32x4 __attribute__((ext_vector_type(4)));

constexpr int BATCH = 32, SEQ = 2048, DM = 1024, NCHUNK = 2, BC = BATCH / NCHUNK, TC = BC * SEQ;
constexpr int PHW = 4352, NINP = 7680, DFF = 2816, NUP = 5632;
constexpr float LOG2E = 1.4426950408889634f;
constexpr size_t MiB = 1u << 20;
constexpr size_t WS_CTL = 0, CTL_BYTES = 32768, CTL_BAR = 4096;
constexpr size_t WS_W = 1 * MiB, LW = 40 * MiB;
constexpr size_t W_IN = 0, W_BR = 15 * MiB, W_O = 18 * MiB, W_UP = 20 * MiB, W_DN = 31 * MiB, W_1T = 37 * MiB, W_2T = 38 * MiB, W_B1 = 38 * MiB + 65536;
constexpr size_t WS_XN = 82 * MiB, WS_KC = 146 * MiB, WS_VC = 147 * MiB, WS_F = 148 * MiB, WS_HB = 150 * MiB  , WS_R = 214 * MiB;
constexpr size_t R_PH = 0, R_MG = 272 * MiB, R_GT = 464 * MiB, R_OA = 468 * MiB, R_OB = 500 * MiB, R_OC = 532 * MiB, R_MP = 0, R_UG = 0, R_ACT = 352 * MiB;
constexpr size_t WS_END = WS_R + 564 * MiB;
constexpr int L_KT = 0, L_VT = 18432, L_B1 = 36864  , L_MISC = 73728  , L_OX = 0  , L_SEL = 110592, L_UNI = L_SEL + 256, L_UQ = L_SEL + 512, L_FT = L_SEL + 1024  ;
constexpr int LDS_BYTES = 131072 + 1024;
constexpr int IMPS = 33;

struct Params { const float* in[22]; float* out; unsigned char* ws; int ph_lo, ph_hi; };

__device__ __forceinline__ float bf2f(unsigned short v) { return __uint_as_float(((unsigned)v) << 16); }
__device__ __forceinline__ float sigm(float x) { return __builtin_amdgcn_rcpf(1.0f + __builtin_amdgcn_exp2f(-1.4426950408889634f * x)); }
__device__ __forceinline__ float gelu_tanh(float x) { const float u = 0.7978845608028654f * (x + 0.044715f * x * x * x); return x * __builtin_amdgcn_rcpf(1.0f + __builtin_amdgcn_exp2f(-2.8853900817779268f * u)); }
__device__ __forceinline__ float ex2(float x) { return __builtin_amdgcn_exp2f(x); }
__device__ __forceinline__ f32x16 mfma32(bf16x8 a, bf16x8 b, f32x16 c) { return __builtin_amdgcn_mfma_f32_32x32x16_bf16(a, b, c, 0, 0, 0); }
__device__ __forceinline__ f32x4 mfma16(bf16x8 a, bf16x8 b, f32x4 c) { return __builtin_amdgcn_mfma_f32_16x16x32_bf16(a, b, c, 0, 0, 0); }
__device__ __forceinline__ bf16x8 vtr2(const LAS unsigned char* p, int step) {
    const v4i16 a = __builtin_amdgcn_ds_read_tr16_b64_v4i16((LAS v4i16*)p);
    const v4i16 b = __builtin_amdgcn_ds_read_tr16_b64_v4i16((LAS v4i16*)(p + step));
    return __builtin_shufflevector(a, b, 0, 1, 2, 3, 4, 5, 6, 7);
}
__device__ __forceinline__ bf16x8 pack8(float a0, float a1, float a2, float a3, float a4, float a5, float a6, float a7) {
    u32x4 w; w.x = cvt_pk_bf16(a0, a1); w.y = cvt_pk_bf16(a2, a3); w.z = cvt_pk_bf16(a4, a5); w.w = cvt_pk_bf16(a6, a7);
    return __builtin_bit_cast(bf16x8, w);
}
__device__ __forceinline__ float wave_sum(float v) {
#pragma unroll
    for (int o = 1; o < 64; o <<= 1) v += __shfl_xor(v, o);
    return v;
}

__device__ __forceinline__ int orig_in_col(int c) {
    if (c < 4352) { const int pn = c >> 8, l = c & 255, bj = l >> 7, wc = (l >> 5) & 3, j = l & 31; const int head = 4 * pn + wc, e = 32 * bj + j; return (head < 20 ? head * 64 : head * 64 + 24) + e; }
    if (c < 7424) return 4384 + (c - 4352);
    const int x = c - 7424; if (x < 24) return 1280 + x; if (x < 32) return 4376 + (x - 24); return -1;
}
template <int MODE>
__device__ __forceinline__ void transpose_mat(const float* src, int K, int Nsrc, bf16_t* dst, int Ndst, LAS float* tile, int tid, int ldd = 0) {
    if (ldd == 0) ldd = K;
    const int ntk = K / 64, nt = (Ndst / 64) * ntk;
    const int cc = tid & 63, kr = tid >> 6, c2 = tid >> 3, kc = (tid & 7) * 8;
    float nx[8];
    { const int it = blockIdx.x; if (it < nt) { const int tn = it / ntk, tk = it - tn * ntk; const int sc = MODE ? orig_in_col(tn * 64 + cc) : (tn * 64 + cc);
#pragma unroll
        for (int r = 0; r < 8; ++r) nx[r] = sc >= 0 ? src[(size_t)(tk * 64 + r * 8 + kr) * Nsrc + sc] : 0.f; } }
    for (int it = blockIdx.x; it < nt; it += gridDim.x) {
        const int tn = it / ntk, tk = it - tn * ntk, c0 = tn * 64, k0 = tk * 64;
        float cur[8];
#pragma unroll
        for (int r = 0; r < 8; ++r) cur[r] = nx[r];
        { const int it2 = it + gridDim.x; if (it2 < nt) { const int tn2 = it2 / ntk, tk2 = it2 - tn2 * ntk; const int sc2 = MODE ? orig_in_col(tn2 * 64 + cc) : (tn2 * 64 + cc);
#pragma unroll
            for (int r = 0; r < 8; ++r) nx[r] = sc2 >= 0 ? src[(size_t)(tk2 * 64 + r * 8 + kr) * Nsrc + sc2] : 0.f; } }
#pragma unroll
        for (int r = 0; r < 8; ++r) tile[(r * 8 + kr) * 65 + cc] = cur[r];
        asm volatile("s_waitcnt lgkmcnt(0)" ::: "memory"); __builtin_amdgcn_s_barrier(); asm volatile("" ::: "memory");
        float v[8];
#pragma unroll
        for (int i = 0; i < 8; ++i) v[i] = tile[(kc + i) * 65 + c2];
        u32x4 w; w.x = cvt_pk_bf16(v[0], v[1]); w.y = cvt_pk_bf16(v[2], v[3]); w.z = cvt_pk_bf16(v[4], v[5]); w.w = cvt_pk_bf16(v[6], v[7]);
        *(u32x4*)(dst + (size_t)(c0 + c2) * ldd + k0 + kc) = w;
        asm volatile("s_waitcnt lgkmcnt(0)" ::: "memory"); __builtin_amdgcn_s_barrier(); asm volatile("" ::: "memory");
    }
}
__device__ __forceinline__ void p0_prologue(const Params& p, LAS unsigned char* lds, int tid) {
    LAS float* tile = (LAS float*)lds;
    if (blockIdx.x < 4) {
        const int l = blockIdx.x >> 1, kv = blockIdx.x & 1, n = tid & 127, part = tid >> 7;
        const float* pe = p.in[5] + (size_t)(l * 2 + kv) * 2048; const float* w1 = p.in[6] + (size_t)(l * 2 + kv) * 2048 * 128;
        float s = 0.f;
        for (int k = part * 512; k < part * 512 + 512; ++k) s += pe[k] * w1[(size_t)k * 128 + n];
        tile[part * 128 + n] = s;
        __syncthreads();
        if (tid < 128) { float* b1 = (float*)(p.ws + WS_W + l * LW + W_B1); b1[kv * 128 + tid] = (tile[tid] + tile[128 + tid]) + (tile[256 + tid] + tile[384 + tid]); }
        __syncthreads();
    }
    for (int l = 0; l < 2; ++l) {
        unsigned char* wb = p.ws + WS_W + l * LW;
        transpose_mat<1>(p.in[2] + (size_t)l * 1024 * 7456, 1024, 7456, (bf16_t*)(wb + W_IN), NINP, tile, tid);
        for (int i = 0; i < 3; ++i) transpose_mat<0>(p.in[15] + (size_t)(l * 3 + i) * 512 * 1024, 512, 1024, (bf16_t*)(wb + W_BR) + (size_t)i * 512, 1024, tile, tid, 1536);
        transpose_mat<0>(p.in[16] + (size_t)l * 1024 * 1024, 1024, 1024, (bf16_t*)(wb + W_O), 1024, tile, tid);
        transpose_mat<0>(p.in[18] + (size_t)l * 1024 * NUP, 1024, NUP, (bf16_t*)(wb + W_UP), NUP, tile, tid);
        transpose_mat<0>(p.in[21] + (size_t)l * DFF * 1024, DFF, 1024, (bf16_t*)(wb + W_DN), 1024, tile, tid);
        for (int kv = 0; kv < 2; ++kv) {
            transpose_mat<0>(p.in[6] + (size_t)(l * 2 + kv) * 2048 * 128, 2048, 128, (bf16_t*)(wb + W_1T) + (size_t)kv * 128 * 2048, 128, tile, tid);
            transpose_mat<0>(p.in[7] + (size_t)(l * 2 + kv) * 128 * 64, 128, 64, (bf16_t*)(wb + W_2T) + (size_t)kv * 64 * 128, 64, tile, tid);
        }
    }
}

template <bool SRC_BF16>
__device__ __forceinline__ void norm_phase(const void* srcv, const float* g, bf16_t* XN, int wid, int lane) {
    f32x4 gv[4];
#pragma unroll
    for (int i = 0; i < 4; ++i) gv[i] = *(const f32x4*)(g + 4 * (lane + 64 * i));
    for (int row0 = (blockIdx.x * 8 + wid) * 4; row0 < TC; row0 += gridDim.x * 8 * 4) {
        f32x4 v[4][4]; float ss[4];
#pragma unroll
        for (int r = 0; r < 4; ++r)
#pragma unroll
            for (int i = 0; i < 4; ++i) {
                if (SRC_BF16) { const u32x2 w = *(const u32x2*)((const bf16_t*)srcv + (size_t)(row0 + r) * 1024 + 4 * (lane + 64 * i));
                    v[r][i][0] = __uint_as_float(w.x << 16); v[r][i][1] = __uint_as_float(w.x & 0xffff0000u); v[r][i][2] = __uint_as_float(w.y << 16); v[r][i][3] = __uint_as_float(w.y & 0xffff0000u); }
                else v[r][i] = *(const f32x4*)((const float*)srcv + (size_t)(row0 + r) * 1024 + 4 * (lane + 64 * i)); }
#pragma unroll
        for (int r = 0; r < 4; ++r) { float s = 0.f;
#pragma unroll
            for (int i = 0; i < 4; ++i) s += (v[r][i][0] * v[r][i][0] + v[r][i][1] * v[r][i][1]) + (v[r][i][2] * v[r][i][2] + v[r][i][3] * v[r][i][3]);
            ss[r] = wave_sum(s); }
#pragma unroll
        for (int r = 0; r < 4; ++r) { const float rr = rsqrtf(ss[r] * (1.0f / 1024.0f) + 1e-6f);
#pragma unroll
            for (int i = 0; i < 4; ++i) { const f32x4 o = v[r][i] * rr * gv[i]; u32x2 w; w.x = cvt_pk_bf16(o[0], o[1]); w.y = cvt_pk_bf16(o[2], o[3]); *(u32x2*)(XN + (size_t)(row0 + r) * 1024 + 4 * (lane + 64 * i)) = w; } }
    }
}

__device__ __forceinline__ void prep_phase(const Params& p, LAS unsigned char* lds, int layer, int wid, int lane) {
    unsigned char* ws = p.ws; unsigned char* wb = ws + WS_W + layer * LW;
    const bf16_t* PH = (const bf16_t*)(ws + WS_R + R_PH);
    const float* GT = (const float*)(ws + WS_R + R_GT);
    const int l16 = lane & 15, G = lane >> 4, grp = wid >> 2, wq = wid & 3;
    for (int wu0 = blockIdx.x * 2; wu0 < 512; wu0 += gridDim.x * 2) {
        const int wu = wu0 + grp;
        const int nt = wu & 7, kv = (wu >> 3) & 1, g = (wu >> 4) & 1, b = wu >> 5;
        const int n = nt * 16 + l16; const int nn = n < 127 ? n : 126;
        const bf16_t* w1t = (const bf16_t*)(wb + W_1T) + (size_t)kv * 128 * 2048;
        const bf16_t* w2t = (const bf16_t*)(wb + W_2T) + (size_t)kv * 64 * 128;
        const float* b1 = (const float*)(wb + W_B1) + kv * 128;
        const bf16_t* src = PH + (size_t)(b * SEQ + 16 * nn) * PHW + (8 + kv * 2 + g) * 64 + 8 * G;
        const bf16_t* wa = w1t + (size_t)l16 * 2048 + 8 * G;
        f32x4 acc[8];
#pragma unroll
        for (int mt = 0; mt < 8; ++mt) acc[mt] = (f32x4){0.f, 0.f, 0.f, 0.f};
        for (int ks0 = wq * 16; ks0 < wq * 16 + 16; ks0 += 4) {
            bf16x8 bfr[4], afr[4][8];
#pragma unroll
            for (int q = 0; q < 4; ++q) { const int ks = ks0 + q; bfr[q] = *(const bf16x8*)(src + (size_t)(ks >> 1) * PHW + (ks & 1) * 32);
#pragma unroll
                for (int mt = 0; mt < 8; ++mt) afr[q][mt] = *(const bf16x8*)(wa + (size_t)mt * 16 * 2048 + ks * 32); }
#pragma unroll
            for (int q = 0; q < 4; ++q)
#pragma unroll
                for (int mt = 0; mt < 8; ++mt) acc[mt] = mfma16(afr[q][mt], bfr[q], acc[mt]);
        }
        LAS f32x4* red = (LAS f32x4*)(lds + (grp * 3) * 8192);
        if (wq > 0) {
#pragma unroll
            for (int mt = 0; mt < 8; ++mt) red[(wq - 1) * 512 + mt * 64 + lane] = acc[mt];
        }
        __syncthreads();
        if (wq == 0) {
#pragma unroll
            for (int mt = 0; mt < 8; ++mt) acc[mt] = ((acc[mt] + red[mt * 64 + lane]) + red[512 + mt * 64 + lane]) + red[1024 + mt * 64 + lane];
#pragma unroll
            for (int mt = 0; mt < 8; ++mt) { const f32x4 bb = *(const f32x4*)(b1 + 16 * mt + 4 * G);
#pragma unroll
                for (int j = 0; j < 4; ++j) acc[mt][j] = gelu_tanh(acc[mt][j] + bb[j]); }
            f32x4 oc[4];
#pragma unroll
            for (int dt = 0; dt < 4; ++dt) oc[dt] = (f32x4){0.f, 0.f, 0.f, 0.f};
#pragma unroll
            for (int s = 0; s < 4; ++s) {
                const bf16x8 bfr = pack8(acc[2 * s][0], acc[2 * s][1], acc[2 * s][2], acc[2 * s][3], acc[2 * s + 1][0], acc[2 * s + 1][1], acc[2 * s + 1][2], acc[2 * s + 1][3]);
#pragma unroll
                for (int dt = 0; dt < 4; ++dt) {
                    const bf16_t* ap = w2t + (size_t)(16 * dt + l16) * 128 + 32 * s + 4 * G;
                    const u32x2 lo = *(const u32x2*)ap, hi = *(const u32x2*)(ap + 16);
                    u32x4 w; w.x = lo.x; w.y = lo.y; w.z = hi.x; w.w = hi.y;
                    oc[dt] = mfma16(__builtin_bit_cast(bf16x8, w), bfr, oc[dt]);
                }
            }
            if (kv == 0) {
                float ss = 0.f;
#pragma unroll
                for (int dt = 0; dt < 4; ++dt) ss += (oc[dt][0] * oc[dt][0] + oc[dt][1] * oc[dt][1]) + (oc[dt][2] * oc[dt][2] + oc[dt][3] * oc[dt][3]);
                ss += __shfl_xor(ss, 16); ss += __shfl_xor(ss, 32);
                const float r = rsqrtf(ss * (1.0f / 64.0f) + 1e-6f);
                const float* kg = p.in[4] + (size_t)layer * 192;
#pragma unroll
                for (int dt = 0; dt < 4; ++dt) { const f32x4 gg = *(const f32x4*)(kg + 16 * dt + 4 * G); oc[dt] = oc[dt] * r * gg; }
            }
            bf16_t* dst = (bf16_t*)(ws + (kv ? WS_VC : WS_KC)) + ((size_t)(b * 2 + g) * 128 + n) * 64 + 4 * G;
            const bool live = n < 127;
#pragma unroll
            for (int dt = 0; dt < 4; ++dt) { u32x2 w; w.x = live ? cvt_pk_bf16(oc[dt][0], oc[dt][1]) : 0u; w.y = live ? cvt_pk_bf16(oc[dt][2], oc[dt][3]) : 0u; *(u32x2*)(dst + 16 * dt) = w; }
        } else if (wq == 1 && wu < 128) {
            const int bh = wu, bb_ = bh >> 3, h = bh & 7;
            const float fb = p.in[14][layer * 8 + h];
            const float* gp = GT + (size_t)(bb_ * SEQ + 32 * lane) * 32 + 24 + h;
            float v[32]; float run = 0.f;
#pragma unroll
            for (int i = 0; i < 32; ++i) { const float x = gp[(size_t)i * 32] + fb; const float lsg = fminf(x, 0.f) - log1pf(__expf(-fabsf(x))); run += lsg; v[i] = run; }
            float incl = run;
#pragma unroll
            for (int o = 1; o < 64; o <<= 1) { const float t_ = __shfl_up(incl, o); if (lane >= o) incl += t_; }
            const float excl = incl - run;
            float* fo = (float*)(ws + WS_F) + (size_t)bh * SEQ + 32 * lane;
#pragma unroll
            for (int i = 0; i < 32; i += 4) *(f32x4*)(fo + i) = (f32x4){v[i] + excl, v[i + 1] + excl, v[i + 2] + excl, v[i + 3] + excl} * (-LOG2E);
        }
        __syncthreads();
    }
}

typedef float f32x2_t __attribute__((ext_vector_type(2))); typedef __bf16 bf16x2_t __attribute__((ext_vector_type(2)));
__device__ __forceinline__ unsigned cvtpk(float lo, float hi) { const f32x2_t v = {lo, hi}; const bf16x2_t r = __builtin_convertvector(v, bf16x2_t); return __builtin_bit_cast(unsigned, r); }
__device__ __forceinline__ bf16x8 pack8n(float a0, float a1, float a2, float a3, float a4, float a5, float a6, float a7) {
    u32x4 w; w.x = cvtpk(a0, a1); w.y = cvtpk(a2, a3); w.z = cvtpk(a4, a5); w.w = cvtpk(a6, a7);
    return __builtin_bit_cast(bf16x8, w);
}
constexpr float QKB = 16.0f;
template <bool FOX, int DV>
__device__ __forceinline__ void attn_tile64(bool MASKED, const LAS unsigned char* Kt, int krow, const LAS unsigned char* Vt, int vrow, const bf16x8 (&qf)[4], f32x16 (&o)[DV / 32], f32x16& lacc,
                                            int lane, int tpos, int kbase, float slope2, float rowc, bool rowsel, int win, const LAS float* Ft) {
    __builtin_amdgcn_sched_barrier(0);
    const int l32 = lane & 31, g = lane >> 5;
    f32x16 s[2];
    if (FOX) {
#pragma unroll
        for (int kb = 0; kb < 2; ++kb)
#pragma unroll
            for (int a = 0; a < 4; ++a) { const f32x4 f = *(const LAS f32x4*)(Ft + 32 * kb + 8 * a + 4 * g); s[kb][4 * a] = f[0] - rowc; s[kb][4 * a + 1] = f[1] - rowc; s[kb][4 * a + 2] = f[2] - rowc; s[kb][4 * a + 3] = f[3] - rowc; }
    } else {
        const float base = slope2 * (float)(kbase + 4 * g - tpos) - QKB;
#pragma unroll
        for (int kb = 0; kb < 2; ++kb)
#pragma unroll
            for (int j = 0; j < 16; ++j) s[kb][j] = fmaf(slope2, (float)(32 * kb + 8 * (j >> 2) + (j & 3)), base);
    }
    bf16x8 kf[2][4];
#pragma unroll
    for (int kb = 0; kb < 2; ++kb)
#pragma unroll
        for (int ks = 0; ks < 4; ++ks) kf[kb][ks] = *(const LAS bf16x8*)(Kt + (32 * kb + l32) * krow + (16 * ks + 8 * g) * 2);
    const LAS unsigned char* vb = Vt + (4 * g + ((lane & 15) >> 2)) * vrow + (16 * ((lane >> 4) & 1) + 4 * (lane & 3)) * 2;
#pragma unroll
    for (int ks = 0; ks < 4; ++ks)
#pragma unroll
        for (int kb = 0; kb < 2; ++kb) s[kb] = mfma32(kf[kb][ks], qf[ks], s[kb]);
    bf16x8 va[2][2][2];
#pragma unroll
    for (int kb = 0; kb < 2; ++kb)
#pragma unroll
        for (int kk = 0; kk < 2; ++kk) va[0][kb][kk] = vtr2(vb + (32 * kb + 16 * kk) * vrow, 8 * vrow);
    __builtin_amdgcn_sched_barrier(0);
    if (MASKED) {
        const int rel = tpos - kbase - 4 * g;
#pragma unroll
        for (int kb = 0; kb < 2; ++kb)
#pragma unroll
            for (int j = 0; j < 16; ++j) { const int c = 32 * kb + 8 * (j >> 2) + (j & 3); const bool ok = rowsel && (c <= rel) && (rel - c < win); s[kb][j] = ok ? s[kb][j] : -1e30f; }
    }
#pragma unroll
    for (int kb = 0; kb < 2; ++kb)
#pragma unroll
        for (int j = 0; j < 16; ++j) s[kb][j] = ex2(s[kb][j]);
    bf16x8 pb[2][2];
#pragma unroll
    for (int kb = 0; kb < 2; ++kb)
#pragma unroll
        for (int kk = 0; kk < 2; ++kk) pb[kb][kk] = pack8n(s[kb][8 * kk], s[kb][8 * kk + 1], s[kb][8 * kk + 2], s[kb][8 * kk + 3], s[kb][8 * kk + 4], s[kb][8 * kk + 5], s[kb][8 * kk + 6], s[kb][8 * kk + 7]);
    const bf16x8 ones = (bf16x8){0x3F80, 0x3F80, 0x3F80, 0x3F80, 0x3F80, 0x3F80, 0x3F80, 0x3F80};
#pragma unroll
    for (int kb = 0; kb < 2; ++kb)
#pragma unroll
        for (int kk = 0; kk < 2; ++kk) lacc = mfma32(ones, pb[kb][kk], lacc);
#pragma unroll
    for (int dt = 0; dt < DV / 32; ++dt) {
        if (dt + 1 < DV / 32) {
#pragma unroll
            for (int kb = 0; kb < 2; ++kb)
#pragma unroll
                for (int kk = 0; kk < 2; ++kk) va[(dt + 1) & 1][kb][kk] = vtr2(vb + (32 * kb + 16 * kk) * vrow + 64 * (dt + 1), 8 * vrow);
        }
#pragma unroll
        for (int kb = 0; kb < 2; ++kb)
#pragma unroll
            for (int kk = 0; kk < 2; ++kk) o[dt] = mfma32(va[dt & 1][kb][kk], pb[kb][kk], o[dt]);
        __builtin_amdgcn_sched_barrier(0);
    }
    __builtin_amdgcn_sched_barrier(0);
}

__device__ __forceinline__ void zero16(f32x16& v) {
#pragma unroll
    for (int j = 0; j < 16; ++j) v[j] = 0.f;
}

__device__ __forceinline__ void fox_unit(const Params& p, LAS unsigned char* lds, int b, int h, int qb, int tid, int wid, int lane) {
    unsigned char* ws = p.ws;
    const bf16_t* PH = (const bf16_t*)(ws + WS_R + R_PH); bf16_t* OC = (bf16_t*)(ws + WS_R + R_OA) + 1024;
    const float* nF2 = (const float*)(ws + WS_F) + (size_t)(b * 8 + h) * SEQ;
    const int l32 = lane & 31, g = lane >> 5, tokbase = b * SEQ;
    const int q0 = 256 * qb + 32 * wid, tpos = q0 + l32;
    bf16x8 qf[4];
#pragma unroll
    for (int ks = 0; ks < 4; ++ks) qf[ks] = *(const bf16x8*)(PH + (size_t)(tokbase + tpos) * PHW + (44 + h) * 64 + 16 * ks + 8 * g);
    f32x16 o[2], lacc; zero16(o[0]); zero16(o[1]); zero16(lacc);
    const float rowc = nF2[tpos] + QKB;
    const int ntiles = 4 * qb + 4, srow = tid >> 3, sch = tid & 7;
    const bf16_t* kg = PH + (size_t)(tokbase + srow) * PHW + (52 + h) * 64 + sch * 8;
    const bf16_t* vg = PH + (size_t)(tokbase + srow) * PHW + (60 + h) * 64 + sch * 8;
    u32x4 kA, vA, kB, vB; f32x4 fA, fB;
    { const int n_ = ntiles;
      kA = *(const u32x4*)(kg + (size_t)(0) * 64 * PHW); vA = *(const u32x4*)(vg + (size_t)(0) * 64 * PHW); fA = *(const f32x4*)(nF2 + (0) * 64 + 4 * (tid & 15)); if (n_ > 1) { kB = *(const u32x4*)(kg + (size_t)(1) * 64 * PHW); vB = *(const u32x4*)(vg + (size_t)(1) * 64 * PHW); fB = *(const f32x4*)(nF2 + (1) * 64 + 4 * (tid & 15)); }
      *(LAS u32x4*)(lds + 0 + L_KT + srow * 144 + sch * 16) = kA; *(LAS u32x4*)(lds + 0 + L_VT + srow * 192 + sch * 16) = vA; if (tid < 16) *(LAS f32x4*)(lds + L_FT + 0 * 256 + tid * 16) = fA; if (n_ > 2) { kA = *(const u32x4*)(kg + (size_t)(2) * 64 * PHW); vA = *(const u32x4*)(vg + (size_t)(2) * 64 * PHW); fA = *(const f32x4*)(nF2 + (2) * 64 + 4 * (tid & 15)); }
      __syncthreads();
#pragma unroll 1
      for (int i_ = 0; i_ < n_; i_ += 2) {
        if (i_ + 1 < n_) { *(LAS u32x4*)(lds + L_B1 + L_KT + srow * 144 + sch * 16) = kB; *(LAS u32x4*)(lds + L_B1 + L_VT + srow * 192 + sch * 16) = vB; if (tid < 16) *(LAS f32x4*)(lds + L_FT + 1 * 256 + tid * 16) = fB; if (i_ + 3 < n_) { kB = *(const u32x4*)(kg + (size_t)((i_ + 3)) * 64 * PHW); vB = *(const u32x4*)(vg + (size_t)((i_ + 3)) * 64 * PHW); fB = *(const f32x4*)(nF2 + ((i_ + 3)) * 64 + 4 * (tid & 15)); } }
        if (64 * i_ <= q0 + 31) attn_tile64<true, 64>(64 * i_ + 63 > q0, lds + 0 + L_KT, 144, lds + 0 + L_VT, 192, qf, o, lacc, lane, tpos, 64 * i_, 0.f, rowc, true, 1 << 30, (const LAS float*)(lds + L_FT + 0 * 256));
        __syncthreads();
        if (i_ + 1 < n_) {
          if (i_ + 2 < n_) { *(LAS u32x4*)(lds + 0 + L_KT + srow * 144 + sch * 16) = kA; *(LAS u32x4*)(lds + 0 + L_VT + srow * 192 + sch * 16) = vA; if (tid < 16) *(LAS f32x4*)(lds + L_FT + 0 * 256 + tid * 16) = fA; if (i_ + 4 < n_) { kA = *(const u32x4*)(kg + (size_t)((i_ + 4)) * 64 * PHW); vA = *(const u32x4*)(vg + (size_t)((i_ + 4)) * 64 * PHW); fA = *(const f32x4*)(nF2 + ((i_ + 4)) * 64 + 4 * (tid & 15)); } }
          if (64 * (i_ + 1) <= q0 + 31) attn_tile64<true, 64>(64 * (i_ + 1) + 63 > q0, lds + L_B1 + L_KT, 144, lds + L_B1 + L_VT, 192, qf, o, lacc, lane, tpos, 64 * (i_ + 1), 0.f, rowc, true, 1 << 30, (const LAS float*)(lds + L_FT + 1 * 256));
          __syncthreads();
        }
      }
    }
    const float inv = 1.0f / lacc[0];
    bf16_t* op = OC + (size_t)(tokbase + tpos) * 1536 + h * 64 + 4 * g;
#pragma unroll
    for (int dt = 0; dt < 2; ++dt)
#pragma unroll
        for (int a = 0; a < 4; ++a) { u32x2 w; w.x = cvt_pk_bf16(o[dt][4 * a] * inv, o[dt][4 * a + 1] * inv); w.y = cvt_pk_bf16(o[dt][4 * a + 2] * inv, o[dt][4 * a + 3] * inv); *(u32x2*)(op + 32 * dt + 8 * a) = w; }
}

__device__ __forceinline__ void diff_unit(const Params& p, LAS unsigned char* lds, int layer, int b, int h, int qt, int tid, int wid, int lane) {
    unsigned char* ws = p.ws;
    const bf16_t* PH = (const bf16_t*)(ws + WS_R + R_PH); bf16_t* OB = (bf16_t*)(ws + WS_R + R_OA) + 512;
    const int l32 = lane & 31, g = lane >> 5, tokbase = b * SEQ, c = wid >> 2, wq = wid & 3;
    const int q0 = 128 * qt + 32 * wq, tpos = q0 + l32;
    const float* lv = p.in[10] + (size_t)layer * 256;
    const float lam_init = 0.8f - 0.6f * __expf(-0.3f * (float)layer);
    const float lam = __expf(wave_sum(lv[lane] * lv[64 + lane])) - __expf(wave_sum(lv[128 + lane] * lv[192 + lane])) + lam_init;
    bf16x8 qf[4];
#pragma unroll
    for (int ks = 0; ks < 4; ++ks) qf[ks] = *(const bf16x8*)(PH + (size_t)(tokbase + tpos) * PHW + (20 + 2 * h + c) * 64 + 16 * ks + 8 * g);
    const float slope2 = ex2(-2.0f * (float)(h + 1)) * LOG2E;
    f32x16 o[4], lacc; zero16(o[0]); zero16(o[1]); zero16(o[2]); zero16(o[3]); zero16(lacc);
    const int ntiles = 2 * qt + 2;
    const int r0 = tid >> 4, ch = tid & 15;
    const bf16_t* kg = PH + (size_t)(tokbase + r0) * PHW + (28 + 2 * h) * 64 + ch * 8;
    const bf16_t* vg = PH + (size_t)(tokbase + r0) * PHW + (36 + 2 * h) * 64 + ch * 8;
    u32x4 kA0, kA1, vA0, vA1, kB0, kB1, vB0, vB1;
    { const int n_ = ntiles;
      { const size_t off = (size_t)(0) * 64 * PHW; kA0 = *(const u32x4*)(kg + off); kA1 = *(const u32x4*)(kg + off + (size_t)32 * PHW); vA0 = *(const u32x4*)(vg + off); vA1 = *(const u32x4*)(vg + off + (size_t)32 * PHW); } if (n_ > 1) { { const size_t off = (size_t)(1) * 64 * PHW; kB0 = *(const u32x4*)(kg + off); kB1 = *(const u32x4*)(kg + off + (size_t)32 * PHW); vB0 = *(const u32x4*)(vg + off); vB1 = *(const u32x4*)(vg + off + (size_t)32 * PHW); } }
      *(LAS u32x4*)(lds + 0 + L_KT + r0 * 272 + ch * 16) = kA0; *(LAS u32x4*)(lds + 0 + L_KT + (r0 + 32) * 272 + ch * 16) = kA1; *(LAS u32x4*)(lds + 0 + 17408 + r0 * 320 + ch * 16) = vA0; *(LAS u32x4*)(lds + 0 + 17408 + (r0 + 32) * 320 + ch * 16) = vA1; if (n_ > 2) { { const size_t off = (size_t)(2) * 64 * PHW; kA0 = *(const u32x4*)(kg + off); kA1 = *(const u32x4*)(kg + off + (size_t)32 * PHW); vA0 = *(const u32x4*)(vg + off); vA1 = *(const u32x4*)(vg + off + (size_t)32 * PHW); } }
      __syncthreads();
#pragma unroll 1
      for (int i_ = 0; i_ < n_; i_ += 2) {
        if (i_ + 1 < n_) { *(LAS u32x4*)(lds + 40960 + L_KT + r0 * 272 + ch * 16) = kB0; *(LAS u32x4*)(lds + 40960 + L_KT + (r0 + 32) * 272 + ch * 16) = kB1; *(LAS u32x4*)(lds + 40960 + 17408 + r0 * 320 + ch * 16) = vB0; *(LAS u32x4*)(lds + 40960 + 17408 + (r0 + 32) * 320 + ch * 16) = vB1; if (i_ + 3 < n_) { { const size_t off = (size_t)((i_ + 3)) * 64 * PHW; kB0 = *(const u32x4*)(kg + off); kB1 = *(const u32x4*)(kg + off + (size_t)32 * PHW); vB0 = *(const u32x4*)(vg + off); vB1 = *(const u32x4*)(vg + off + (size_t)32 * PHW); } } }
        if (64 * i_ <= q0 + 31) attn_tile64<false, 128>(64 * i_ + 63 > q0, lds + 0 + L_KT + c * 128, 272, lds + 0 + 17408, 320, qf, o, lacc, lane, tpos, 64 * i_, slope2, 0.f, true, 1 << 30, nullptr);
        __syncthreads();
        if (i_ + 1 < n_) {
          if (i_ + 2 < n_) { *(LAS u32x4*)(lds + 0 + L_KT + r0 * 272 + ch * 16) = kA0; *(LAS u32x4*)(lds + 0 + L_KT + (r0 + 32) * 272 + ch * 16) = kA1; *(LAS u32x4*)(lds + 0 + 17408 + r0 * 320 + ch * 16) = vA0; *(LAS u32x4*)(lds + 0 + 17408 + (r0 + 32) * 320 + ch * 16) = vA1; if (i_ + 4 < n_) { { const size_t off = (size_t)((i_ + 4)) * 64 * PHW; kA0 = *(const u32x4*)(kg + off); kA1 = *(const u32x4*)(kg + off + (size_t)32 * PHW); vA0 = *(const u32x4*)(vg + off); vA1 = *(const u32x4*)(vg + off + (size_t)32 * PHW); } } }
          if (64 * (i_ + 1) <= q0 + 31) attn_tile64<false, 128>(64 * (i_ + 1) + 63 > q0, lds + 40960 + L_KT + c * 128, 272, lds + 40960 + 17408, 320, qf, o, lacc, lane, tpos, 64 * (i_ + 1), slope2, 0.f, true, 1 << 30, nullptr);
          __syncthreads();
        }
      }
    }
    const float inv = 1.0f / lacc[0];
    LAS float* OX = (LAS float*)(lds + L_OX);
    const int ql = 32 * wq + l32;
    if (c == 1) {
        const float f = inv * lam;
#pragma unroll
        for (int dt = 0; dt < 4; ++dt)
#pragma unroll
            for (int j = 0; j < 16; ++j) { const int d = 32 * dt + 8 * (j >> 2) + 4 * g + (j & 3); OX[d * 128 + ql] = o[dt][j] * f; }
    }
    __syncthreads();
    if (c == 0) {
        float ss = 0.f;
#pragma unroll
        for (int dt = 0; dt < 4; ++dt)
#pragma unroll
            for (int j = 0; j < 16; ++j) { const int d = 32 * dt + 8 * (j >> 2) + 4 * g + (j & 3); const float v = o[dt][j] * inv - OX[d * 128 + ql]; o[dt][j] = v; ss += v * v; }
        ss += __shfl_xor(ss, 32);
        const float r = rsqrtf(ss * (1.0f / 128.0f) + 1e-6f) * (1.0f - lam_init);
        const float* sg = p.in[11] + (size_t)layer * 128;
        bf16_t* op = OB + (size_t)(tokbase + tpos) * 1536 + h * 128 + 4 * g;
        f32x4 gg[4][4];
#pragma unroll
        for (int dt = 0; dt < 4; ++dt)
#pragma unroll
            for (int a = 0; a < 4; ++a) gg[dt][a] = *(const f32x4*)(sg + 32 * dt + 8 * a + 4 * g);
#pragma unroll
        for (int dt = 0; dt < 4; ++dt)
#pragma unroll
            for (int a = 0; a < 4; ++a) {
                u32x2 w; w.x = cvt_pk_bf16(o[dt][4 * a] * r * gg[dt][a][0], o[dt][4 * a + 1] * r * gg[dt][a][1]); w.y = cvt_pk_bf16(o[dt][4 * a + 2] * r * gg[dt][a][2], o[dt][4 * a + 3] * r * gg[dt][a][3]); *(u32x2*)(op + 32 * dt + 8 * a) = w; }
    }
}

__device__ __forceinline__ void nsa_unit(const Params& p, LAS unsigned char* lds, int b, int gq, int tq, int tid, int wid, int lane) {
    unsigned char* ws = p.ws;
    const bf16_t* PH = (const bf16_t*)(ws + WS_R + R_PH); bf16_t* OA = (bf16_t*)(ws + WS_R + R_OA);
    const float* GT = (const float*)(ws + WS_R + R_GT);
    const int l32 = lane & 31, g = lane >> 5, tokbase = b * SEQ, r = wid >> 1, th = wid & 1, head = gq * 4 + r;
    const int t0 = 64 * tq, tl = 32 * th + l32, tpos = t0 + tl;
    const float slope2 = ex2(-(float)(head + 1)) * LOG2E;
    bf16x8 qf[4];
#pragma unroll
    for (int ks = 0; ks < 4; ++ks) qf[ks] = *(const bf16x8*)(PH + (size_t)(tokbase + tpos) * PHW + head * 64 + 16 * ks + 8 * g);
    const float* gtp = GT + (size_t)(tokbase + tpos) * 32 + head;
    const float gc = sigm(gtp[0]), gs = sigm(gtp[8]), gw = sigm(gtp[16]);
    const int srow = tid >> 3, sch = tid & 7, j0 = tq >= 4 ? tq - 4 : 0;
    const u32x4 kS0 = *(const u32x4*)(PH + (size_t)(tokbase + srow) * PHW + (12 + gq) * 64 + sch * 8), vS0 = *(const u32x4*)(PH + (size_t)(tokbase + srow) * PHW + (14 + gq) * 64 + sch * 8);
    const u32x4 kW0 = *(const u32x4*)(PH + (size_t)(tokbase + j0 * 64 + srow) * PHW + (16 + gq) * 64 + sch * 8), vW0 = *(const u32x4*)(PH + (size_t)(tokbase + j0 * 64 + srow) * PHW + (18 + gq) * 64 + sch * 8);
    f32x16 tot[2];
    LAS float* IMP = (LAS float*)(lds + L_MISC);
    LAS unsigned* SEL = (LAS unsigned*)(lds + L_SEL);
    {
        const bf16_t* kc = (const bf16_t*)(ws + WS_KC) + (size_t)(b * 2 + gq) * 128 * 64;
        const bf16_t* vc = (const bf16_t*)(ws + WS_VC) + (size_t)(b * 2 + gq) * 128 * 64;
        __syncthreads();
#pragma unroll
        for (int i = 0; i < 2; ++i) { const int idx = tid + 512 * i, row = idx >> 3, ch = idx & 7;
            *(LAS u32x4*)(lds + L_KT + row * 144 + ch * 16) = *(const u32x4*)(kc + row * 64 + ch * 8);
            *(LAS u32x4*)(lds + L_VT + row * 192 + ch * 16) = *(const u32x4*)(vc + row * 64 + ch * 8); }
        __syncthreads();
        f32x16 s[4];
#pragma unroll
        for (int kb = 0; kb < 4; ++kb) { zero16(s[kb]);
#pragma unroll
            for (int ks = 0; ks < 4; ++ks) { const bf16x8 a = *(const LAS bf16x8*)(lds + L_KT + (32 * kb + l32) * 144 + (16 * ks + 8 * g) * 2); s[kb] = mfma32(a, qf[ks], s[kb]); } }
        float mx = -1e30f;
#pragma unroll
        for (int kb = 0; kb < 4; ++kb)
#pragma unroll
            for (int j = 0; j < 16; ++j) { const int n = 32 * kb + 8 * (j >> 2) + 4 * g + (j & 3); const int dist = tpos - (16 * n + 31);
                const float v = dist >= 0 ? s[kb][j] + slope2 * (float)(16 * n) : -1e30f; s[kb][j] = v; mx = fmaxf(mx, v); }
        mx = fmaxf(mx, __shfl_xor(mx, 32));
        float psum = 0.f;
#pragma unroll
        for (int kb = 0; kb < 4; ++kb)
#pragma unroll
            for (int j = 0; j < 16; ++j) { const float pv = s[kb][j] > -1e29f ? ex2(s[kb][j] - mx) : 0.f; s[kb][j] = pv; psum += pv; }
        psum += __shfl_xor(psum, 32);
        const float invl = psum > 0.f ? 1.0f / psum : 0.f;
#pragma unroll
        for (int kb = 0; kb < 4; ++kb) s[kb] *= invl;
        float prevrecv = 0.f;
#pragma unroll
        for (int kb = 0; kb < 4; ++kb)
#pragma unroll
            for (int a = 0; a < 4; ++a) {
                const float run = (s[kb][4 * a] + s[kb][4 * a + 1]) + (s[kb][4 * a + 2] + s[kb][4 * a + 3]);
                const float recv = __shfl_xor(s[kb][4 * a + 3], 32);
                const float val = run + (g ? recv : prevrecv);
                prevrecv = recv;
                IMP[(r * 64 + tl) * IMPS + 8 * kb + 2 * a + g] = val;
            }
        zero16(tot[0]); zero16(tot[1]);
        const LAS unsigned char* vb = lds + L_VT + (4 * g + ((lane & 15) >> 2)) * 192 + (16 * ((lane >> 4) & 1) + 4 * (lane & 3)) * 2;
#pragma unroll
        for (int kb = 0; kb < 4; ++kb)
#pragma unroll
            for (int kk = 0; kk < 2; ++kk) {
                const bf16x8 pb = pack8(s[kb][8 * kk], s[kb][8 * kk + 1], s[kb][8 * kk + 2], s[kb][8 * kk + 3], s[kb][8 * kk + 4], s[kb][8 * kk + 5], s[kb][8 * kk + 6], s[kb][8 * kk + 7]);
#pragma unroll
                for (int dt = 0; dt < 2; ++dt) { const bf16x8 a = vtr2(vb + (32 * kb + 16 * kk) * 192 + 64 * dt, 8 * 192); tot[dt] = mfma32(a, pb, tot[dt]); }
            }
        tot[0] *= gc; tot[1] *= gc;
    }
    __syncthreads();
    if (wid == 0) {
        float sc[32];
#pragma unroll
        for (int j = 0; j < 32; ++j) {
            const float imp = ((IMP[(0 * 64 + lane) * IMPS + j] + IMP[(1 * 64 + lane) * IMPS + j]) + IMP[(2 * 64 + lane) * IMPS + j]) + IMP[(3 * 64 + lane) * IMPS + j];
            const bool forced = (j == 0) || (j == tq) || (j == tq - 1);
            sc[j] = j <= tq ? (forced ? imp + 1.0e4f : imp) : -1e30f;
            if ((j & 3) == 3) __builtin_amdgcn_sched_barrier(0);
        }
        unsigned mask = 0u;
        for (int k = 0; k < 8; ++k) {
            float best = -3.0e38f; int idx = 0;
#pragma unroll
            for (int j = 0; j < 32; ++j) { const float v = ((mask >> j) & 1u) ? -3.0e38f : sc[j]; if (v > best) { best = v; idx = j; } }
            mask |= 1u << idx;
        }
        mask &= (tq == 31) ? 0xffffffffu : ((2u << tq) - 1u);
        SEL[lane] = mask;
        unsigned un = mask;
#pragma unroll
        for (int o = 1; o < 64; o <<= 1) un |= (unsigned)__shfl_xor((int)un, o);
        if (lane == 0) { SEL[64] = un; int c = 0; for (unsigned r_ = un; r_; r_ &= r_ - 1u) { ((LAS int*)(lds + L_SEL + 272))[c] = __ffs((int)r_) - 1; ++c; } *(LAS int*)(lds + L_SEL + 268) = c; }
    }
    __syncthreads();
    const unsigned uni = (unsigned)__builtin_amdgcn_readfirstlane((int)SEL[64]);
    const unsigned mysel = SEL[tl];
    {
        f32x16 o[2], lacc; zero16(o[0]); zero16(o[1]); zero16(lacc);
        const bf16_t* kg = PH + (size_t)(tokbase + srow) * PHW + (12 + gq) * 64 + sch * 8;
        const bf16_t* vg = PH + (size_t)(tokbase + srow) * PHW + (14 + gq) * 64 + sch * 8;
        u32x4 kA, vA, kB, vB;
        const LAS int* LIST = (const LAS int*)(lds + L_SEL + 272);
        { const int n_ = __builtin_amdgcn_readfirstlane(*(const LAS int*)(lds + L_SEL + 268));
          kA = kS0; vA = vS0; if (n_ > 1) { { const int bk_ = __builtin_amdgcn_readfirstlane(LIST[1]); kB = *(const u32x4*)(kg + (size_t)bk_ * 64 * PHW); vB = *(const u32x4*)(vg + (size_t)bk_ * 64 * PHW); } }
          *(LAS u32x4*)(lds + 0 + L_KT + srow * 144 + sch * 16) = kA; *(LAS u32x4*)(lds + 0 + L_VT + srow * 192 + sch * 16) = vA; if (n_ > 2) { { const int bk_ = __builtin_amdgcn_readfirstlane(LIST[2]); kA = *(const u32x4*)(kg + (size_t)bk_ * 64 * PHW); vA = *(const u32x4*)(vg + (size_t)bk_ * 64 * PHW); } }
          __syncthreads();
#pragma unroll 1
          for (int i_ = 0; i_ < n_; i_ += 2) {
            if (i_ + 1 < n_) { *(LAS u32x4*)(lds + L_B1 + L_KT + srow * 144 + sch * 16) = kB; *(LAS u32x4*)(lds + L_B1 + L_VT + srow * 192 + sch * 16) = vB; if (i_ + 3 < n_) { { const int bk_ = __builtin_amdgcn_readfirstlane(LIST[(i_ + 3)]); kB = *(const u32x4*)(kg + (size_t)bk_ * 64 * PHW); vB = *(const u32x4*)(vg + (size_t)bk_ * 64 * PHW); } } }
            { const int j = __builtin_amdgcn_readfirstlane(LIST[i_]); const bool rs = ((mysel >> j) & 1u) != 0u; attn_tile64<false, 64>(j == tq || __builtin_amdgcn_ballot_w64(rs) != ~0ull, lds + 0 + L_KT, 144, lds + 0 + L_VT, 192, qf, o, lacc, lane, tpos, 64 * j, slope2, 0.f, rs, 1 << 30, nullptr); }
            __syncthreads();
            if (i_ + 1 < n_) {
              if (i_ + 2 < n_) { *(LAS u32x4*)(lds + 0 + L_KT + srow * 144 + sch * 16) = kA; *(LAS u32x4*)(lds + 0 + L_VT + srow * 192 + sch * 16) = vA; if (i_ + 4 < n_) { { const int bk_ = __builtin_amdgcn_readfirstlane(LIST[(i_ + 4)]); kA = *(const u32x4*)(kg + (size_t)bk_ * 64 * PHW); vA = *(const u32x4*)(vg + (size_t)bk_ * 64 * PHW); } } }
              { const int j = __builtin_amdgcn_readfirstlane(LIST[(i_ + 1)]); const bool rs = ((mysel >> j) & 1u) != 0u; attn_tile64<false, 64>(j == tq || __builtin_amdgcn_ballot_w64(rs) != ~0ull, lds + L_B1 + L_KT, 144, lds + L_B1 + L_VT, 192, qf, o, lacc, lane, tpos, 64 * j, slope2, 0.f, rs, 1 << 30, nullptr); }
              __syncthreads();
            }
          }
        }
        const float lt = lacc[0], f = lt > 0.f ? gs / lt : 0.f;
        tot[0] += o[0] * f; tot[1] += o[1] * f;
    }
    {
        f32x16 o[2], lacc; zero16(o[0]); zero16(o[1]); zero16(lacc);
        const bf16_t* kg = PH + (size_t)(tokbase + srow) * PHW + (16 + gq) * 64 + sch * 8;
        const bf16_t* vg = PH + (size_t)(tokbase + srow) * PHW + (18 + gq) * 64 + sch * 8;
        u32x4 kA, vA, kB, vB;
        { const int n_ = tq - j0 + 1;
          kA = kW0; vA = vW0; if (n_ > 1) { kB = *(const u32x4*)(kg + (size_t)(j0 + 1) * 64 * PHW); vB = *(const u32x4*)(vg + (size_t)(j0 + 1) * 64 * PHW); }
          *(LAS u32x4*)(lds + 0 + L_KT + srow * 144 + sch * 16) = kA; *(LAS u32x4*)(lds + 0 + L_VT + srow * 192 + sch * 16) = vA; if (n_ > 2) { kA = *(const u32x4*)(kg + (size_t)(j0 + 2) * 64 * PHW); vA = *(const u32x4*)(vg + (size_t)(j0 + 2) * 64 * PHW); }
          __syncthreads();
#pragma unroll 1
          for (int i_ = 0; i_ < n_; i_ += 2) {
            if (i_ + 1 < n_) { *(LAS u32x4*)(lds + L_B1 + L_KT + srow * 144 + sch * 16) = kB; *(LAS u32x4*)(lds + L_B1 + L_VT + srow * 192 + sch * 16) = vB; if (i_ + 3 < n_) { kB = *(const u32x4*)(kg + (size_t)(j0 + (i_ + 3)) * 64 * PHW); vB = *(const u32x4*)(vg + (size_t)(j0 + (i_ + 3)) * 64 * PHW); } }
            { const int j = j0 + i_; attn_tile64<false, 64>(j == tq || j == tq - 4, lds + 0 + L_KT, 144, lds + 0 + L_VT, 192, qf, o, lacc, lane, tpos, 64 * j, slope2, 0.f, true, 256, nullptr); }
            __syncthreads();
            if (i_ + 1 < n_) {
              if (i_ + 2 < n_) { *(LAS u32x4*)(lds + 0 + L_KT + srow * 144 + sch * 16) = kA; *(LAS u32x4*)(lds + 0 + L_VT + srow * 192 + sch * 16) = vA; if (i_ + 4 < n_) { kA = *(const u32x4*)(kg + (size_t)(j0 + (i_ + 4)) * 64 * PHW); vA = *(const u32x4*)(vg + (size_t)(j0 + (i_ + 4)) * 64 * PHW); } }
              { const int j = j0 + (i_ + 1); attn_tile64<false, 64>(j == tq || j == tq - 4, lds + L_B1 + L_KT, 144, lds + L_B1 + L_VT, 192, qf, o, lacc, lane, tpos, 64 * j, slope2, 0.f, true, 256, nullptr); }
              __syncthreads();
            }
          }
        }
        const float lt = lacc[0], f = lt > 0.f ? gw / lt : 0.f;
        tot[0] += o[0] * f; tot[1] += o[1] * f;
    }
    bf16_t* op = OA + (size_t)(tokbase + tpos) * 1536 + head * 64 + 4 * g;
#pragma unroll
    for (int dt = 0; dt < 2; ++dt)
#pragma unroll
        for (int a = 0; a < 4; ++a) { u32x2 w; w.x = cvt_pk_bf16(tot[dt][4 * a], tot[dt][4 * a + 1]); w.y = cvt_pk_bf16(tot[dt][4 * a + 2], tot[dt][4 * a + 3]); *(u32x2*)(op + 32 * dt + 8 * a) = w; }
}

#ifndef ATT_REP_TYPES
#define ATT_REP_TYPES 7
#endif
#ifndef ATT_REPS
#define ATT_REPS 1
#endif
__device__ __forceinline__ void attn_phase(const Params& p, LAS unsigned char* lds, int layer, unsigned* ctr, int tid_in, int tmask = 7) {
    LAS int* uq = (LAS int*)(lds + L_UQ);
    for (;;) {
        __syncthreads();
        if (tid_in == 0) *uq = (int)atomicAdd(ctr, 1u);
        __syncthreads();
        const int u_ = __builtin_amdgcn_readfirstlane(*uq);
        if (u_ >= 3072 * ATT_REPS) break;
        const int u = u_ % 3072; if (u_ >= 3072) tmask = ATT_REP_TYPES;
        int tid = tid_in; asm volatile("" : "+v"(tid));
        const int lane = tid & 63, wid = __builtin_amdgcn_readfirstlane(tid >> 6);
        const int lv = u / 192, idx = u - lv * 192;
        if (idx < 64) { if (tmask & 1) diff_unit(p, lds, layer, idx >> 2, idx & 3, 15 - lv, tid, wid, lane); }
        else if (idx < 128) { const int k = (idx - 64) + 64 * (lv & 1); if (tmask & 2) fox_unit(p, lds, k >> 3, k & 7, 7 - (lv >> 1), tid, wid, lane); }
        else { const int k = idx - 128; if (tmask & 4) nsa_unit(p, lds, k >> 2, (k >> 1) & 1, 31 - 2 * lv - (k & 1), tid, wid, lane); }
    }
}

__device__ __forceinline__ void unpack8(const u32x4 w, float (&x)[8]) {
#pragma unroll
    for (int i = 0; i < 4; ++i) { x[2 * i] = __uint_as_float(w[i] << 16); x[2 * i + 1] = __uint_as_float(w[i] & 0xffff0000u); }
}
__device__ __forceinline__ void conv_phase(const Params& p, int layer, int tid) {
    const bf16_t* UG = (const bf16_t*)(p.ws + WS_R + R_UG); bf16_t* ACT = (bf16_t*)(p.ws + WS_R + R_ACT);
    const float* cw = p.in[19] + (size_t)layer * 3 * DFF; const float* cb = p.in[20] + (size_t)layer * DFF;
    constexpr int NCG = DFF / 8, RUN = 32, NITEM = (TC / RUN) * NCG;
    for (int it = blockIdx.x * 512 + tid; it < NITEM; it += gridDim.x * 512) {
        const int run = it / NCG, c = (it - run * NCG) * 8, t0 = run * RUN;
        float w0[8], w1[8], w2[8], bb[8];
#pragma unroll
        for (int hf = 0; hf < 2; ++hf) { const f32x4 a = *(const f32x4*)(cw + c + 4 * hf), b2 = *(const f32x4*)(cw + DFF + c + 4 * hf), c2 = *(const f32x4*)(cw + 2 * DFF + c + 4 * hf), d = *(const f32x4*)(cb + c + 4 * hf);
#pragma unroll
            for (int i = 0; i < 4; ++i) { w0[4 * hf + i] = a[i]; w1[4 * hf + i] = b2[i]; w2[4 * hf + i] = c2[i]; bb[4 * hf + i] = d[i]; } }
        const bf16_t* up = UG + (size_t)t0 * NUP + c;
        float x0[8], x1[8];
        const bool head = (t0 & (SEQ - 1)) == 0;
        { u32x4 a = (u32x4){0u, 0u, 0u, 0u}, b2 = a; if (!head) { a = *(const u32x4*)(up - 2 * NUP); b2 = *(const u32x4*)(up - NUP); } unpack8(a, x0); unpack8(b2, x1); }
#pragma unroll 1
        for (int r0 = 0; r0 < RUN; r0 += 4) {
            u32x4 uw[4], gw[4];
#pragma unroll
            for (int q = 0; q < 4; ++q) { uw[q] = *(const u32x4*)(up + (size_t)(r0 + q) * NUP); gw[q] = *(const u32x4*)(up + (size_t)(r0 + q) * NUP + DFF); }
#pragma unroll
            for (int q = 0; q < 4; ++q) {
                float x2[8], xg[8], res[8]; unpack8(uw[q], x2); unpack8(gw[q], xg);
#pragma unroll
                for (int i = 0; i < 8; ++i) { res[i] = gelu_tanh(bb[i] + w0[i] * x0[i] + w1[i] * x1[i] + w2[i] * x2[i]) * xg[i]; x0[i] = x1[i]; x1[i] = x2[i]; }
                u32x4 w; w.x = cvt_pk_bf16(res[0], res[1]); w.y = cvt_pk_bf16(res[2], res[3]); w.z = cvt_pk_bf16(res[4], res[5]); w.w = cvt_pk_bf16(res[6], res[7]);
                *(u32x4*)(ACT + (size_t)(t0 + r0 + q) * DFF + c) = w;
            }
        }
    }
}

#define XB_TMO      128
#define XB_XCNT(j)  (256  + 64 * (j))
#define XB_XSUB(j)  (1280 + 64 * (j))
#define XB_XGEN(j)  (2304 + 64 * (j))
#define XB_TOP      3328
#define XB_TOPGEN   3392
#define XCD_BAR_WORDS 3456
#define XB_SPIN_CAP (1u << 18)

__device__ __forceinline__ unsigned xb_ld(unsigned* p)              { return __hip_atomic_load(p, __ATOMIC_RELAXED, __HIP_MEMORY_SCOPE_AGENT); }
__device__ __forceinline__ unsigned xb_add(unsigned* p, unsigned v) { return __hip_atomic_fetch_add(p, v, __ATOMIC_RELAXED, __HIP_MEMORY_SCOPE_AGENT); }
__device__ __forceinline__ unsigned xb_xcc_id() { return (unsigned)__builtin_amdgcn_s_getreg((3 << 11) | 20) & 0xFu; }
#define XB_SPIN(cond, bar) do { unsigned _sp = 0; while (cond) { __builtin_amdgcn_s_sleep(1); \
    if ((++_sp & 255u) == 0u) { if (xb_ld(&(bar)[XB_TMO])) break; if (_sp > XB_SPIN_CAP) { atomicAdd(&(bar)[XB_TMO], 1u); break; } } } } while (0)

struct XcdBarrier {
    unsigned* bar; unsigned x;
    volatile LAS unsigned* st;
};

__device__ __forceinline__ XcdBarrier xcd_barrier_post(unsigned* bar, volatile LAS unsigned* st) {
    XcdBarrier b; b.bar = bar; b.x = xb_xcc_id(); b.st = st;
    if (threadIdx.x == 0) (void)xb_add(&bar[XB_XCNT(b.x)], 1u);
    return b;
}
__device__ __forceinline__ void xcd_barrier_complete(unsigned* bar, unsigned x, unsigned& nloc, unsigned& nx) {
    const unsigned G = gridDim.x * gridDim.y * gridDim.z;
    unsigned sum, cnt, mine, sp = 0u;
    for (;;) {
        sum = 0u; cnt = 0u; mine = 0u;
#pragma unroll
        for (unsigned j = 0; j < 16; ++j) { const unsigned c = xb_ld(&bar[XB_XCNT(j)]); sum += c; cnt += (c > 0u) ? 1u : 0u; mine = (j == x) ? c : mine; }
        if (sum == G) break;
        __builtin_amdgcn_s_sleep(1);
        if ((++sp & 255u) == 0u) { if (xb_ld(&bar[XB_TMO])) break; if (sp > XB_SPIN_CAP) { atomicAdd(&bar[XB_TMO], 1u); break; } }
    }
    nloc = mine > 0u ? mine : 1u; nx = cnt > 0u ? cnt : 1u;
}

__device__ __forceinline__ void xcd_barrier(const XcdBarrier& b) {
    asm volatile("s_waitcnt vmcnt(0)" ::: "memory");
    __syncthreads();
    if (threadIdx.x == 0) {
        unsigned* bar = b.bar;
        __builtin_amdgcn_s_waitcnt(0);
        unsigned nloc = b.st[0], nx = b.st[1];
        if (nloc == 0u) { xcd_barrier_complete(bar, b.x, nloc, nx); b.st[0] = nloc; b.st[1] = nx; }
        const unsigned old = xb_add(&bar[XB_XSUB(b.x)], 1u);
        const unsigned gen = old / nloc;
        if (old + 1u == (gen + 1u) * nloc) {
            __builtin_amdgcn_fence(__ATOMIC_RELEASE, "agent");
            asm volatile("s_waitcnt vmcnt(0)" ::: "memory");
            const unsigned og = xb_add(&bar[XB_TOP], 1u);
            const unsigned tg = og / nx;
            if (og + 1u == (tg + 1u) * nx) xb_add(&bar[XB_TOPGEN], 1u);
            else XB_SPIN(xb_ld(&bar[XB_TOPGEN]) == tg, bar);
            __builtin_amdgcn_fence(__ATOMIC_ACQUIRE, "agent");
            xb_add(&bar[XB_XGEN(b.x)], 1u);
            asm volatile("s_waitcnt vmcnt(0)" ::: "memory");
        } else {
            XB_SPIN(xb_ld(&bar[XB_XGEN(b.x)]) == gen, bar);
            __builtin_amdgcn_fence(__ATOMIC_ACQUIRE, "agent");
            asm volatile("s_waitcnt vmcnt(0)" ::: "memory");
        }
    }
    __syncthreads();
}

constexpr int NPH = 1 + NCHUNK * 2 * 10;
#ifndef PH_MASK
#define PH_MASK 0xfff
#endif
#define EN(k) ((PH_MASK >> (k)) & 1)
#ifndef REP_MASK
#define REP_MASK 0
#endif

#ifndef GEMM_SP2
#define GEMM_SP2 true
#endif
#ifndef GEMM_ALIGN
#define GEMM_ALIGN true
#endif

__global__ void __launch_bounds__(512) fwd_megakernel(Params p) {
    extern __shared__ __attribute__((aligned(16))) unsigned char smem[];
    LAS unsigned char* lds = (LAS unsigned char*)smem;
    cg::grid_group grid = cg::this_grid();
    volatile LAS unsigned* xst = (volatile LAS unsigned*)(lds + 131072 + 512);
    if (threadIdx.x < 2) xst[threadIdx.x] = 0u;
    __syncthreads();
    const XcdBarrier xbar = xcd_barrier_post((unsigned*)(p.ws + WS_CTL + CTL_BAR), xst);
    for (int ph = p.ph_lo; ph < p.ph_hi; ++ph) {
        int tid0 = threadIdx.x; asm volatile("" : "+v"(tid0));
        unsigned char* ws = p.ws; asm volatile("" : "+s"(ws));
        if (ph == 0) { if (EN(10)) p0_prologue(p, lds, tid0); }
        else {
            const int q = ph - 1, chunk = q / 20, layer = (q / 10) & 1, k = q % 10;
            unsigned char* wb = ws + WS_W + layer * LW;
            bf16_t* XN = (bf16_t*)(ws + WS_XN);
            float* fout = p.out + (size_t)chunk * TC * DM; const float* xin = p.in[0] + (size_t)chunk * TC * DM; bf16_t* HB = (bf16_t*)(ws + WS_HB);
            pg8::StaticOrder S;
            for (int rep = 0; rep <= ((REP_MASK >> k) & 1); ++rep) {
            if (rep) xcd_barrier(xbar);
            int tid = tid0; asm volatile("" : "+v"(tid));
            const int lane = tid & 63, wid = __builtin_amdgcn_readfirstlane(tid >> 6);
            if (k == 0) { if (EN(0)) { if (layer == 0) norm_phase<false>(xin, p.in[1], XN, wid, lane); else norm_phase<true>(HB, p.in[1] + DM, XN, wid, lane); } }
            else if (k == 1) { if (EN(1)) {
                pg8::Gemm g{XN, (const bf16_t*)(wb + W_IN), TC, NINP, 1024}; S.init(TC, NINP, gridDim.x, blockIdx.x);
                pg8::EpiIn E{(bf16_t*)(ws + WS_R + R_PH), (bf16_t*)(ws + WS_R + R_MG), (float*)(ws + WS_R + R_GT), p.in[3] + layer * 64, p.in[4] + layer * 192, p.in[8] + layer * 64, p.in[9] + layer * 64, p.in[12] + layer * 64, p.in[13] + layer * 64};
                pg8::gemm_phase<pg8::EpiIn, pg8::StaticOrder, GEMM_ALIGN, GEMM_SP2>(lds, g, S, E); }
            }
            else if (k == 2) { if (EN(2)) prep_phase(p, lds, layer, wid, lane); }
            else if (k == 3) { if (EN(3)) attn_phase(p, lds, layer, (unsigned*)(ws + WS_CTL) + 16 * (chunk * 2 + layer) + 8 * rep, tid, 7); }
            else if (k == 4) { if (EN(4)) {
                S.init(TC, 1024, gridDim.x, blockIdx.x);
                pg8::Gemm g{(const bf16_t*)(ws + WS_R + R_OA), (const bf16_t*)(wb + W_BR), TC, 1024, 1536};
                pg8::EpiMerge E{(const bf16_t*)(ws + WS_R + R_MG), XN}; pg8::gemm_phase<pg8::EpiMerge, pg8::StaticOrder, GEMM_ALIGN, GEMM_SP2>(lds, g, S, E); }
            }
            else if (k == 5) { if (EN(5)) {
                pg8::Gemm g{XN, (const bf16_t*)(wb + W_O), TC, 1024, 1024}; S.init(TC, 1024, gridDim.x, blockIdx.x);
                if (layer == 0) { pg8::EpiRes<false, true> E{xin, HB}; pg8::gemm_phase<pg8::EpiRes<false, true>, pg8::StaticOrder, GEMM_ALIGN, GEMM_SP2>(lds, g, S, E); }
                else { pg8::EpiRes<true, true> E{HB, HB}; pg8::gemm_phase<pg8::EpiRes<true, true>, pg8::StaticOrder, GEMM_ALIGN, GEMM_SP2>(lds, g, S, E); } }
            }
            else if (k == 6) { if (EN(6)) norm_phase<true>(HB, p.in[17] + layer * DM, XN, wid, lane); }
            else if (k == 7) { if (EN(7)) {
                pg8::Gemm g{XN, (const bf16_t*)(wb + W_UP), TC, NUP, 1024}; S.init(TC, NUP, gridDim.x, blockIdx.x);
                pg8::EpiStore E{(bf16_t*)(ws + WS_R + R_UG), NUP}; pg8::gemm_phase<pg8::EpiStore, pg8::StaticOrder, GEMM_ALIGN, GEMM_SP2>(lds, g, S, E); }
            }
            else if (k == 8) { if (EN(8)) conv_phase(p, layer, tid); }
            else { if (EN(9)) {
                pg8::Gemm g{(const bf16_t*)(ws + WS_R + R_ACT), (const bf16_t*)(wb + W_DN), TC, 1024, DFF}; S.init(TC, 1024, gridDim.x, blockIdx.x);
                if (layer == 0) { pg8::EpiRes<true, true> E{HB, HB}; pg8::gemm_phase<pg8::EpiRes<true, true>, pg8::StaticOrder, GEMM_ALIGN, GEMM_SP2>(lds, g, S, E); }
                else { pg8::EpiRes<true, false> E{HB, fout}; pg8::gemm_phase<pg8::EpiRes<true, false>, pg8::StaticOrder, GEMM_ALIGN, GEMM_SP2>(lds, g, S, E); } }
            }
            }
        }
        if (ph + 1 < p.ph_hi) { if (p.ph_lo < 0) grid.sync(); else xcd_barrier(xbar); }
    }
}
}

extern "C" void kernel_launch(void* const* d_in, const int* in_sizes, int n_in, void* d_out, int out_size, void* d_ws, size_t ws_size, hipStream_t stream) {
    static int grid = 0;
    if (grid == 0) {
        if (n_in != 22 || ws_size < mk::WS_END) { fprintf(stderr, "kernel_launch: unexpected n_in %d or ws %zu (< %zu)\n", n_in, ws_size, (size_t)mk::WS_END); grid = -1; return; }
        int dev = 0, cus = 0, per_cu = 0;
        hipGetDevice(&dev); hipDeviceGetAttribute(&cus, hipDeviceAttributeMultiprocessorCount, dev);
        if (hipFuncSetAttribute((const void*)mk::fwd_megakernel, hipFuncAttributeMaxDynamicSharedMemorySize, mk::LDS_BYTES) != hipSuccess) { fprintf(stderr, "hipFuncSetAttribute failed\n"); grid = -1; return; }
        if (hipOccupancyMaxActiveBlocksPerMultiprocessor(&per_cu, (const void*)mk::fwd_megakernel, 512, mk::LDS_BYTES) != hipSuccess || per_cu < 1) { fprintf(stderr, "occupancy query: %d\n", per_cu); per_cu = 1; }
        (void)hipGetLastError();
        grid = cus * per_cu;
    }
    if (grid < 0) return;
    hipMemsetAsync((char*)d_ws + mk::WS_CTL, 0, mk::CTL_BYTES, stream);
    mk::Params p{};
    for (int i = 0; i < 22; ++i) p.in[i] = (const float*)d_in[i];
    p.out = (float*)d_out; p.ws = (unsigned char*)d_ws; p.ph_lo = 0; p.ph_hi = mk::NPH;
    void* args[] = {&p};
    hipError_t e = hipLaunchCooperativeKernel((void*)mk::fwd_megakernel, dim3(grid), dim3(512), args, mk::LDS_BYTES, stream);
    if (e != hipSuccess) fprintf(stderr, "cooperative launch failed: %s (grid %d)\n", hipGetErrorString(e), grid);
}
```
